# Optimizing an MI355X kernel written in HIP

```python
import jax, jax.numpy as jnp
from jax import lax
import numpy as np

D_MODEL = 1024
BATCH = 16
SEQ = 2048
DEPTH = 4
DEC_BATCH = 16
DEC_SEQ = 32
PAST_LEN = 2048

CHUNK = 64
N_META = 16
HEAD_DIM = 64
H_A = 8
KV_A = 2
G_A = H_A // KV_A
WINDOW = 128
WIN_CHUNKS = WINDOW // CHUNK
H_B = 4
DK_B = 64
DV_B = 128
GATE_RANK = 16
GATE_TAU = 16.0
H_C = 16
Q_BLOCK = 128
D_FF = 4 * D_MODEL
ROPE_THETA = 10000.0
EPS = 1e-6
NEG = -1e30
SCALE = HEAD_DIM ** -0.5
N_EVEN = (DEPTH + 1) // 2
N_ODD = DEPTH // 2
AB_SIZES = (H_A * HEAD_DIM, KV_A * HEAD_DIM, KV_A * HEAD_DIM, H_B * DK_B, H_B * DK_B, H_B * DV_B, H_B * DV_B, GATE_RANK)
P_AB = sum(AB_SIZES)
MIX_AB = H_A * HEAD_DIM + H_B * DV_B
C_SIZES = (H_C * HEAD_DIM, H_C * HEAD_DIM, H_C * HEAD_DIM, H_C)
P_C = sum(C_SIZES)
MIX_C = H_C * HEAD_DIM

kernel_name = 'hybrid_stream_swa_gla_fox_step'


def split_cols(z, sizes):
    idx = [int(i) for i in np.cumsum(sizes)[:-1]]
    return jnp.split(z, idx, axis=-1)


def rmsnorm(x, g):
    xf = x.astype(jnp.float32)
    y = xf * lax.rsqrt(jnp.mean(xf * xf, axis=-1, keepdims=True) + EPS)
    return (y * g.astype(jnp.float32)).astype(x.dtype)


def rope(x, pos):
    half = HEAD_DIM // 2
    inv = ROPE_THETA ** (-jnp.arange(half, dtype=jnp.float32) / half)
    ang = pos.astype(jnp.float32)[:, None] * inv[None, :]
    cos = jnp.cos(ang)[None, :, None, :]
    sin = jnp.sin(ang)[None, :, None, :]
    xf = x.astype(jnp.float32)
    x1, x2 = xf[..., :half], xf[..., half:]
    return jnp.concatenate([x1 * cos - x2 * sin, x2 * cos + x1 * sin], axis=-1).astype(x.dtype)


def mlp(h, w_up, w_down):
    u = jax.nn.relu(h @ w_up)
    return (u * u) @ w_down


def ab_project(h, w_in, qn, kn, w_gate, b_gate, pos):
    B_, L = h.shape[:2]
    qa, ka, va, qb, kb, vb, rb, glr = split_cols(h @ w_in, AB_SIZES)
    qa = rope(rmsnorm(qa.reshape(B_, L, H_A, HEAD_DIM), qn), pos)
    ka = rope(rmsnorm(ka.reshape(B_, L, KV_A, HEAD_DIM), kn), pos)
    va = va.reshape(B_, L, KV_A, HEAD_DIM)
    qb = qb.reshape(B_, L, H_B, DK_B) * (DK_B ** -0.5)
    kb = kb.reshape(B_, L, H_B, DK_B)
    vb = vb.reshape(B_, L, H_B, DV_B)
    gb = jax.nn.log_sigmoid((glr @ w_gate + b_gate).astype(jnp.float32)) / GATE_TAU
    gb = gb.reshape(B_, L, H_B, DK_B)
    return qa, ka, va, qb, kb, vb, rb, gb


def sink_attend(s, sink, v, eq):
    m = jnp.maximum(jnp.max(s, axis=-1, keepdims=True), sink)
    p = jnp.exp(s - m)
    den = jnp.sum(p, axis=-1, keepdims=True) + jnp.exp(sink - m)
    return jnp.einsum(eq, p / den, v.astype(jnp.float32))


def swa_prompt(q, k, v, sink):
    B_, L = q.shape[:2]
    lead = CHUNK - N_META
    nb = (L + lead) // CHUNK
    front = lead + WIN_CHUNKS * CHUNK
    qb = jnp.pad(q, ((0, 0), (lead, 0), (0, 0), (0, 0))).reshape(B_, nb, CHUNK, KV_A, G_A, HEAD_DIM)
    kp = jnp.pad(k, ((0, 0), (front, 0), (0, 0), (0, 0))).reshape(B_, nb + WIN_CHUNKS, CHUNK, KV_A, HEAD_DIM)
    vp = jnp.pad(v, ((0, 0), (front, 0), (0, 0), (0, 0))).reshape(B_, nb + WIN_CHUNKS, CHUNK, KV_A, HEAD_DIM)
    valid = (jnp.arange((nb + WIN_CHUNKS) * CHUNK) >= front).reshape(nb + WIN_CHUNKS, CHUNK)
    kband = jnp.concatenate([kp[:, i:i + nb] for i in range(WIN_CHUNKS + 1)], axis=2)
    vband = jnp.concatenate([vp[:, i:i + nb] for i in range(WIN_CHUNKS + 1)], axis=2)
    vmask = jnp.concatenate([valid[i:i + nb] for i in range(WIN_CHUNKS + 1)], axis=1)
    s = jnp.einsum('bnqhgd,bnshd->bnhgqs', qb, kband, preferred_element_type=jnp.float32) * SCALE
    s = jnp.where(vmask[None, :, None, None, None, :], s, NEG)
    sk = sink.astype(jnp.float32).reshape(1, 1, KV_A, G_A, 1, 1)
    o = sink_attend(s, sk, vband, 'bnhgqs,bnshd->bnqhgd')
    return o.reshape(B_, nb * CHUNK, H_A * HEAD_DIM)[:, lead:].astype(q.dtype)


def swa_sample(q, k_new, v_new, ck, cv, sink):
    B_, T = q.shape[:2]
    kk = jnp.concatenate([ck.astype(k_new.dtype), k_new], axis=1)
    vv = jnp.concatenate([cv.astype(v_new.dtype), v_new], axis=1)
    qg = q.reshape(B_, T, KV_A, G_A, HEAD_DIM)
    s = jnp.einsum('bqhgd,bshd->bhgqs', qg, kk, preferred_element_type=jnp.float32) * SCALE
    sk = sink.astype(jnp.float32).reshape(1, KV_A, G_A, 1, 1)
    o = sink_attend(s, sk, vv, 'bhgqs,bshd->bqhgd')
    return o.reshape(B_, T, H_A * HEAD_DIM).astype(q.dtype), kk[:, -WINDOW:], vv[:, -WINDOW:]


def gla_chunk(S, q, k, v, g):
    C = q.shape[2]
    b = jnp.cumsum(g, axis=2)
    causal = jnp.tril(jnp.ones((C, C), dtype=bool))
    diff = b[:, :, :, None, :] - b[:, :, None, :, :]
    decay = jnp.exp(jnp.where(causal[:, :, None], diff, -jnp.inf))
    att = jnp.einsum('bhtd,bhsd,bhtsd->bhts', q, k, decay)
    o = jnp.einsum('bhtd,bhdv->bhtv', q * jnp.exp(b), S) + jnp.einsum('bhts,bhsv->bhtv', att, v)
    bl = b[:, :, -1:, :]
    S_new = jnp.exp(bl[:, :, 0, :, None]) * S + jnp.einsum('bhsd,bhsv->bhdv', k * jnp.exp(bl - b), v)
    return S_new, o


def gla_prompt(q, k, v, g):
    B_, L = q.shape[:2]
    lead = CHUNK - N_META
    f32 = jnp.float32
    padf = lambda t: jnp.pad(t.astype(f32), ((0, 0), (lead, 0), (0, 0), (0, 0)))
    Lp = L + lead
    nb = Lp // CHUNK
    to_chunks = lambda t: t.reshape(B_, nb, CHUNK, H_B, t.shape[-1]).transpose(1, 0, 3, 2, 4)
    xs = (to_chunks(padf(q)), to_chunks(padf(k)), to_chunks(padf(v)), to_chunks(padf(g)))
    S0 = jnp.zeros((B_, H_B, DK_B, DV_B), f32)
    S, o = lax.scan(lambda S, c: gla_chunk(S, *c), S0, xs)
    o = o.transpose(1, 0, 3, 2, 4).reshape(B_, Lp, H_B, DV_B)[:, lead:]
    return o.astype(q.dtype), S


def gla_sample(q, k, v, g, S):
    f32 = jnp.float32
    tr = lambda t: t.astype(f32).transpose(0, 2, 1, 3)
    S_new, o = gla_chunk(S.astype(f32), tr(q), tr(k), tr(v), tr(g))
    return o.transpose(0, 2, 1, 3).astype(q.dtype), S_new


def ab_output(oa, ob, rb, onorm, w_out):
    B_, L = oa.shape[:2]
    ob = rmsnorm(ob, onorm).reshape(B_, L, H_B * DV_B) * jax.nn.silu(rb)
    return jnp.concatenate([oa, ob], axis=-1) @ w_out


def c_project(h, w_in, b_f, qn, kn):
    B_, L = h.shape[:2]
    q, k, v, fl = split_cols(h @ w_in, C_SIZES)
    q = rmsnorm(q.reshape(B_, L, H_C, HEAD_DIM), qn)
    k = rmsnorm(k.reshape(B_, L, H_C, HEAD_DIM), kn)
    v = v.reshape(B_, L, H_C, HEAD_DIM)
    logf = jax.nn.log_sigmoid((fl + b_f).astype(jnp.float32))
    return q, k, v, logf


def fox_prompt(q, k, v, logf):
    B_, L = q.shape[:2]
    Lp = -(-L // Q_BLOCK) * Q_BLOCK
    padL = lambda t: jnp.pad(t, ((0, 0), (0, Lp - L)) + ((0, 0),) * (t.ndim - 2))
    qp, kp, vp = padL(q), padL(k), padL(v).astype(jnp.float32)
    ct = padL(jnp.cumsum(logf, axis=1)).transpose(0, 2, 1)
    kpos = jnp.arange(Lp)

    def block(i):
        start = i * Q_BLOCK
        qb = lax.dynamic_slice_in_dim(qp, start, Q_BLOCK, axis=1)
        cq = lax.dynamic_slice_in_dim(ct, start, Q_BLOCK, axis=2)
        s = jnp.einsum('bqhd,bkhd->bhqk', qb, kp, preferred_element_type=jnp.float32) * SCALE
        s = s + cq[..., None] - ct[:, :, None, :]
        qpos = start + jnp.arange(Q_BLOCK)
        s = jnp.where(kpos[None, :] <= qpos[:, None], s, NEG)
        p = jax.nn.softmax(s, axis=-1)
        return jnp.einsum('bhqk,bkhd->bqhd', p, vp)

    o = lax.map(block, jnp.arange(Lp // Q_BLOCK))
    o = o.transpose(1, 0, 2, 3, 4).reshape(B_, Lp, MIX_C)[:, :L]
    return o.astype(q.dtype)


def fox_sample(q, k_new, v_new, logf_new, ck, cv, clogf):
    B_, T = q.shape[:2]
    P = ck.shape[1]
    kk = jnp.concatenate([ck.astype(k_new.dtype), k_new], axis=1)
    vv = jnp.concatenate([cv.astype(v_new.dtype), v_new], axis=1).astype(jnp.float32)
    c = jnp.cumsum(jnp.concatenate([clogf.astype(jnp.float32), logf_new], axis=1), axis=1).transpose(0, 2, 1)
    s = jnp.einsum('bqhd,bkhd->bhqk', q, kk, preferred_element_type=jnp.float32) * SCALE
    s = s + c[:, :, P:, None] - c[:, :, None, :]
    mask = jnp.arange(P + T)[None, :] <= (P + jnp.arange(T))[:, None]
    p = jax.nn.softmax(jnp.where(mask, s, NEG), axis=-1)
    o = jnp.einsum('bhqk,bkhd->bqhd', p, vv)
    return o.reshape(B_, T, MIX_C).astype(q.dtype)


def setup_inputs(seed: int = 0) -> dict:
    key = jax.random.key(seed)
    ks = jax.random.split(key, 32)
    f32 = jnp.float32
    nrm = lambda k, shape, s=1.0: jax.random.normal(k, shape, f32) * s
    return {
        'x_prompt': nrm(ks[0], (BATCH, SEQ, D_MODEL)),
        'x_sample': nrm(ks[1], (DEC_BATCH, DEC_SEQ, D_MODEL)),
        'cache_a_k': nrm(ks[2], (N_EVEN, DEC_BATCH, WINDOW, KV_A, HEAD_DIM)),
        'cache_a_v': nrm(ks[3], (N_EVEN, DEC_BATCH, WINDOW, KV_A, HEAD_DIM)),
        'state_b': nrm(ks[4], (N_EVEN, DEC_BATCH, H_B, DK_B, DV_B), 0.5),
        'cache_c_k': nrm(ks[5], (N_ODD, DEC_BATCH, PAST_LEN, H_C, HEAD_DIM)),
        'cache_c_v': nrm(ks[6], (N_ODD, DEC_BATCH, PAST_LEN, H_C, HEAD_DIM)),
        'cache_c_logf': jax.nn.log_sigmoid(2.0 + nrm(ks[7], (N_ODD, DEC_BATCH, PAST_LEN, H_C))),
        'meta_tokens': nrm(ks[8], (N_META, D_MODEL)),
        'norm_mix': 1.0 + nrm(ks[9], (DEPTH, D_MODEL), 0.1),
        'norm_mlp': 1.0 + nrm(ks[10], (DEPTH, D_MODEL), 0.1),
        'w_in_ab': nrm(ks[11], (N_EVEN, D_MODEL, P_AB), D_MODEL ** -0.5),
        'qnorm_a': 1.0 + nrm(ks[12], (N_EVEN, HEAD_DIM), 0.1),
        'knorm_a': 1.0 + nrm(ks[13], (N_EVEN, HEAD_DIM), 0.1),
        'sink_a': nrm(ks[14], (N_EVEN, H_A), 0.5),
        'w_gate_b': nrm(ks[15], (N_EVEN, GATE_RANK, H_B * DK_B), GATE_RANK ** -0.5),
        'b_gate_b': nrm(ks[16], (N_EVEN, H_B * DK_B), 0.1),
        'onorm_b': 1.0 + nrm(ks[17], (N_EVEN, DV_B), 0.1),
        'w_out_ab': nrm(ks[18], (N_EVEN, MIX_AB, D_MODEL), MIX_AB ** -0.5),
        'w_in_c': nrm(ks[19], (N_ODD, D_MODEL, P_C), D_MODEL ** -0.5),
        'b_f_c': 2.0 + nrm(ks[20], (N_ODD, H_C), 0.1),
        'qnorm_c': 1.0 + nrm(ks[21], (N_ODD, HEAD_DIM), 0.1),
        'knorm_c': 1.0 + nrm(ks[22], (N_ODD, HEAD_DIM), 0.1),
        'w_out_c': nrm(ks[23], (N_ODD, MIX_C, D_MODEL), MIX_C ** -0.5),
        'w_up': nrm(ks[24], (DEPTH, D_MODEL, D_FF), D_MODEL ** -0.5),
        'w_down': nrm(ks[25], (DEPTH, D_FF, D_MODEL), D_FF ** -0.5),
    }


def reference(x_prompt, x_sample, cache_a_k, cache_a_v, state_b, cache_c_k, cache_c_v, cache_c_logf,
              meta_tokens, norm_mix, norm_mlp, w_in_ab, qnorm_a, knorm_a, sink_a, w_gate_b, b_gate_b,
              onorm_b, w_out_ab, w_in_c, b_f_c, qnorm_c, knorm_c, w_out_c, w_up, w_down):
    Bp = x_prompt.shape[0]
    meta = jnp.broadcast_to(meta_tokens.astype(x_prompt.dtype)[None], (Bp, N_META, D_MODEL))
    xp = jnp.concatenate([meta, x_prompt], axis=1)
    xs = x_sample
    T = xs.shape[1]
    pos_p = jnp.arange(xp.shape[1])
    pos_s = N_META + PAST_LEN + jnp.arange(T)
    akp, avp, bp, ckp, cvp, cfp = [], [], [], [], [], []
    aks, avs, bs, cks, cvs, cfs = [], [], [], [], [], []
    for l in range(DEPTH):
        i = l // 2
        hp = rmsnorm(xp, norm_mix[l])
        hs = rmsnorm(xs, norm_mix[l])
        if l % 2 == 0:
            qa, ka, va, qb, kb, vb, rb, gb = ab_project(hp, w_in_ab[i], qnorm_a[i], knorm_a[i], w_gate_b[i], b_gate_b[i], pos_p)
            oa = swa_prompt(qa, ka, va, sink_a[i])
            ob, Sp = gla_prompt(qb, kb, vb, gb)
            xp = xp + ab_output(oa, ob, rb, onorm_b[i], w_out_ab[i])
            akp.append(ka[:, -WINDOW:])
            avp.append(va[:, -WINDOW:])
            bp.append(Sp.astype(xp.dtype))
            qa, ka, va, qb, kb, vb, rb, gb = ab_project(hs, w_in_ab[i], qnorm_a[i], knorm_a[i], w_gate_b[i], b_gate_b[i], pos_s)
            oa, nk, nv = swa_sample(qa, ka, va, cache_a_k[i], cache_a_v[i], sink_a[i])
            ob, Ss = gla_sample(qb, kb, vb, gb, state_b[i])
            xs = xs + ab_output(oa, ob, rb, onorm_b[i], w_out_ab[i])
            aks.append(nk)
            avs.append(nv)
            bs.append(Ss.astype(xs.dtype))
        else:
            q, k, v, lf = c_project(hp, w_in_c[i], b_f_c[i], qnorm_c[i], knorm_c[i])
            xp = xp + fox_prompt(q, k, v, lf) @ w_out_c[i]
            ckp.append(k)
            cvp.append(v)
            cfp.append(lf.astype(xp.dtype))
            q, k, v, lf = c_project(hs, w_in_c[i], b_f_c[i], qnorm_c[i], knorm_c[i])
            xs = xs + fox_sample(q, k, v, lf, cache_c_k[i], cache_c_v[i], cache_c_logf[i]) @ w_out_c[i]
            cks.append(k)
            cvs.append(v)
            cfs.append(lf.astype(xs.dtype))
        xp = xp + mlp(rmsnorm(xp, norm_mlp[l]), w_up[l], w_down[l])
        xs = xs + mlp(rmsnorm(xs, norm_mlp[l]), w_up[l], w_down[l])
    y_prompt = xp[:, N_META:]
    return (y_prompt, xs,
            jnp.stack(akp), jnp.stack(avp), jnp.stack(bp), jnp.stack(ckp), jnp.stack(cvp), jnp.stack(cfp),
            jnp.stack(aks), jnp.stack(avs), jnp.stack(bs), jnp.stack(cks), jnp.stack(cvs), jnp.stack(cfs))
```

```cpp
#include <hip/hip_runtime.h>
#include <hip/hip_cooperative_groups.h>
#include <cstdio>
#include <cstdint>
namespace cg = cooperative_groups;
namespace pg8 {
#define PG8_LAS __attribute__((address_space(3)))
typedef unsigned short bf16_t;
typedef short bf16x8 __attribute__((ext_vector_type(8)));
typedef float f32x4 __attribute__((ext_vector_type(4)));
typedef unsigned u32x4 __attribute__((ext_vector_type(4)));
constexpr int BM = 256, BK = 64, HALF = 128, HTB = HALF * BK * 2  , STAGE_BYTES = 8 * HTB, NXCD = 8, WGM = 8;

__host__ __device__ __forceinline__ int lds_byte(int r, int c) { const int st = (r >> 4) * 2 + (c >> 5), rr = r & 15, cc = c & 31, ob = rr * 64 + cc * 2; return st * 1024 + (ob ^ (((ob >> 9) & 1) << 5)); }
__host__ __device__ __forceinline__ void stage_rc(int b, int& R, int& C) { const int st = b / 1024, sb = b % 1024, swz = sb ^ (((sb >> 9) & 1) << 5); R = (st >> 1) * 16 + swz / 64; C = (st & 1) * 32 + (swz % 64) / 2; }
__host__ __device__ __forceinline__ int perm32(int rho) { const int n = rho >> 4, i = rho & 15; return 8 * (i >> 2) + 4 * n + (i & 3); }

struct Unit { int pm, pn, k0; };
struct Gemm { const bf16_t* A; const bf16_t* Bt; int M, N, K, klen; };

struct StaticOrder {
    int nM, nN, nwg, G, c;
    __host__ __device__ void init(int M, int N, int G_, int c_) { nM = M / BM; nN = N / BM; nwg = nM * nN; G = G_; c = c_; }
    __host__ __device__ bool next(int i, Unit& u) const {
        const long L = (long)i * G + c; if (L >= nwg) return false;
        int wgid = (int)L; { const int q = nwg / NXCD, r = nwg % NXCD, xcd = wgid % NXCD, off = wgid / NXCD; wgid = (xcd < r ? xcd * (q + 1) : r * (q + 1) + (xcd - r) * q) + off; }
        const int nig = WGM * nN, gid = wgid / nig, fm = gid * WGM, gsz = (nM - fm) < WGM ? (nM - fm) : WGM;
        u.pm = fm + ((wgid % nig) % gsz); u.pn = (wgid % nig) / gsz; u.k0 = 0; return true;
    }
    __device__ __forceinline__ void a_ready(const Unit&) const {}
    __device__ __forceinline__ void done(const Unit&) const {}
};

__device__ __forceinline__ unsigned cvt_pk_bf16(float lo, float hi) { unsigned r; asm volatile("v_cvt_pk_bf16_f32 %0, %1, %2" : "=v"(r) : "v"(lo), "v"(hi)); return r; }
typedef float f32x2 __attribute__((ext_vector_type(2)));
}
constexpr int DM = 1024, NBAT = 16, LP = 2064, MP = NBAT * LP, TS = 32, MS = 16 * TS, MT = MP + MS, NAB = 2560, NC = 3328, DFF = 4096;
constexpr float LOG2E = 1.4426950408889634f;
static_assert(MT % 256 == 0 && MP % 256 == 0, "rows");
constexpr size_t O_YP = 0, O_YS = O_YP + (size_t)16 * 2048 * 1024, O_AKP = O_YS + (size_t)16 * 32 * 1024, O_AVP = O_AKP + 524288, O_BP = O_AVP + 524288,
    O_CKP = O_BP + 1048576, O_CVP = O_CKP + (size_t)2 * MP * 1024, O_CLFP = O_CVP + (size_t)2 * MP * 1024, O_AKS = O_CLFP + (size_t)2 * MP * 16, O_AVS = O_AKS + 524288,
    O_BS = O_AVS + 524288, O_CKS = O_BS + 1048576, O_CVS = O_CKS + 1048576, O_CLFS = O_CVS + 1048576, O_END = O_CLFS + 16384;
constexpr size_t al256(size_t x) { return (x + 255) & ~(size_t)255; }
constexpr size_t WS_CTL = 0, WS_BAR = 4096, WS_SS = 4096 + 16384, WS_ROPE = WS_SS + al256((size_t)8 * MT * 16 * 4), WS_WAB = WS_ROPE + al256((size_t)2096 * 64 * 4),
    WS_WOAB = WS_WAB + (size_t)2 * NAB * 1024 * 2, WS_WC = WS_WOAB + (size_t)2 * 1024 * 1024 * 2, WS_WOC = WS_WC + (size_t)2 * NC * 1024 * 2,
    WS_WUP = WS_WOC + (size_t)2 * 1024 * 1024 * 2, WS_WDN = WS_WUP + (size_t)4 * 4096 * 1024 * 2, WS_X = WS_WDN + (size_t)4 * 4096 * 1024 * 2,
    WS_XB = WS_X + (size_t)MT * 1024 * 4, WS_MIX = WS_XB + (size_t)MT * 1024 * 2, WS_KAS = WS_MIX + (size_t)MT * 1024 * 2,
    WS_VAS = WS_KAS + (size_t)2 * 16 * 160 * 128 * 2, WS_KCS = WS_VAS + (size_t)2 * 16 * 160 * 128 * 2, WS_VCS = WS_KCS + (size_t)2 * 16 * 2080 * 1024 * 2,
    WS_LFS = WS_VCS + (size_t)2 * 16 * 2080 * 1024 * 2, WS_R = WS_LFS + (size_t)2 * 16 * 2080 * 16 * 4, WS_PB = WS_R + (size_t)MT * 4096 * 2, WS_RS = WS_PB + (size_t)4 * 768 * 1024 * 4, WS_END = WS_RS + (size_t)8 * MT * 4;
constexpr size_t R_QA = 0, R_KA = R_QA + (size_t)MT * 512 * 2, R_VA = R_KA + (size_t)MT * 128 * 2, R_QB = R_VA + (size_t)MT * 128 * 2, R_KB = R_QB + (size_t)MT * 256 * 2,
    R_VB = R_KB + (size_t)MT * 256 * 2, R_RB = R_VB + (size_t)MT * 512 * 2, R_GB = R_RB + (size_t)MT * 512 * 2, R_ABEND = R_GB + (size_t)MT * 256 * 4;
constexpr size_t R_QC = 0, R_KC = R_QC + (size_t)MT * 1024 * 2, R_VC = R_KC + (size_t)MT * 1024 * 2, R_LF = R_VC + (size_t)MT * 1024 * 2, R_CEND = R_LF + (size_t)MT * 16 * 4;
static_assert(R_ABEND <= (size_t)MT * 4096 * 2 && R_CEND <= (size_t)MT * 4096 * 2, "region R");
constexpr int LDS_BYTES = 147456, LDS_SLOT = 147200;

namespace pg8 {
constexpr int cMP = MP, cLP = LP, cMT = MT;
#define LAUNDER(p) do { unsigned lz_ = 0u; asm volatile("" : "+s"(lz_)); (p) = (p) + lz_; } while (0)
typedef __bf16 bf16x2_t __attribute__((ext_vector_type(2)));
__device__ __forceinline__ unsigned pk(float lo, float hi) { f32x2 v = {lo, hi}; bf16x2_t b = __builtin_convertvector(v, bf16x2_t); return __builtin_bit_cast(unsigned, b); }
__device__ __forceinline__ void st8bf(bf16_t* p, const f32x4& a, const f32x4& b) { u32x4 w; w.x = pk(a[0], a[1]); w.y = pk(a[2], a[3]); w.z = pk(b[0], b[1]); w.w = pk(b[2], b[3]); *(u32x4*)p = w; }
__device__ __forceinline__ void st8f(float* p, const f32x4& a, const f32x4& b) { *(f32x4*)p = a; *(f32x4*)(p + 4) = b; }
__device__ __forceinline__ float row_rstd(const float* ss, int row) { const f32x4* p = (const f32x4*)(ss + (size_t)row * 16); const f32x4 a = p[0], b = p[1], c = p[2], d = p[3];
    const float s = (((a[0] + a[1]) + (a[2] + a[3])) + ((b[0] + b[1]) + (b[2] + b[3]))) + (((c[0] + c[1]) + (c[2] + c[3])) + ((d[0] + d[1]) + (d[2] + d[3]))); return rsqrtf(s * (1.f / 1024.f) + 1e-6f); }
__device__ __forceinline__ float logsig(float x) { return fminf(x, 0.f) - __logf(1.f + __expf(-fabsf(x))); }

struct EpiUp {
    static constexpr bool PERM = true, AFTER_DRAIN = false;
    unsigned char* ws; const float* ss;
    __device__ __forceinline__ void operator()(const f32x4 (&acc)[2][2][4][2], const Unit& u, int wr, int wc, int fr, int fq) const {
        const int row0 = u.pm * BM + wr * 64 + fr, col0 = u.pn * BM + wc * 32 + 8 * fq;
        unsigned char* w_ = ws; LAUNDER(w_); bf16_t* H = (bf16_t*)(w_ + WS_R);
        float rs8[8];
#pragma unroll
        for (int r8 = 0; r8 < 8; ++r8) rs8[r8] = ss[row0 + (r8 >> 2) * HALF + (r8 & 3) * 16];
#pragma unroll
        for (int ai = 0; ai < 2; ++ai)
#pragma unroll
            for (int m = 0; m < 4; ++m) { const int row = row0 + ai * HALF + m * 16; const float rs = rs8[ai * 4 + m];
                bf16_t* rp = H + (size_t)row * 4096 + col0;
#pragma unroll
                for (int bj = 0; bj < 2; ++bj) { f32x4 a = acc[ai][bj][m][0] * rs, b = acc[ai][bj][m][1] * rs;
#pragma unroll
                    for (int i = 0; i < 4; ++i) { a[i] = fmaxf(a[i], 0.f); a[i] *= a[i]; b[i] = fmaxf(b[i], 0.f); b[i] *= b[i]; }
                    st8bf(rp + bj * HALF, a, b); }
                asm volatile("" ::: "memory"); }
    }
};

struct EpiRes {
    static constexpr bool PERM = true, AFTER_DRAIN = false;
    unsigned char* ws; float* ssout; int fin; float* out;
    __device__ __forceinline__ void operator()(const f32x4 (&acc)[2][2][4][2], const Unit& u, int wr, int wc, int fr, int fq) const {
        if (fin == 2) return;
        const int row0 = u.pm * BM + wr * 64 + fr, col0 = u.pn * BM + wc * 32 + 8 * fq;
        unsigned char* w_ = ws; float* o_ = out; LAUNDER(w_); LAUNDER(o_); bf16_t* XB = (bf16_t*)(w_ + WS_XB); float* yp = o_ + O_YP; float* ys = o_ + O_YS;
#pragma unroll
        for (int ai = 0; ai < 2; ++ai) {
            u32x4 xr[4][2];
#pragma unroll
            for (int m = 0; m < 4; ++m)
#pragma unroll
                for (int bj = 0; bj < 2; ++bj) xr[m][bj] = *(const u32x4*)(XB + (size_t)(row0 + ai * HALF + m * 16) * 1024 + col0 + bj * HALF);
#pragma unroll
            for (int m = 0; m < 4; ++m) { const int row = row0 + ai * HALF + m * 16; float part = 0.f;
                float* op = nullptr; bool ok = true;
                if (fin) { if (row < cMP) { const int b = row / cLP, p = row - b * cLP; ok = p >= 16; op = yp + ((size_t)(b * 2048 + p - 16)) * 1024 + col0; } else op = ys + (size_t)(row - cMP) * 1024 + col0; }
#pragma unroll
                for (int bj = 0; bj < 2; ++bj) { const u32x4 x = xr[m][bj];
                    f32x4 a = (f32x4){__uint_as_float(x.x << 16), __uint_as_float(x.x & 0xffff0000u), __uint_as_float(x.y << 16), __uint_as_float(x.y & 0xffff0000u)} + acc[ai][bj][m][0];
                    f32x4 b = (f32x4){__uint_as_float(x.z << 16), __uint_as_float(x.z & 0xffff0000u), __uint_as_float(x.w << 16), __uint_as_float(x.w & 0xffff0000u)} + acc[ai][bj][m][1];
                    if (fin) { if (ok) st8f(op + bj * HALF, a, b); }
                    else { st8bf(XB + (size_t)row * 1024 + col0 + bj * HALF, a, b);
                        part += (a[0] * a[0] + a[1] * a[1]) + (a[2] * a[2] + a[3] * a[3]) + (b[0] * b[0] + b[1] * b[1]) + (b[2] * b[2] + b[3] * b[3]); } }
                if (!fin && ssout) { part += __shfl_xor(part, 16); part += __shfl_xor(part, 32); if (fq == 0) ssout[(size_t)row * 16 + u.pn * 4 + wc] = part; } }
            asm volatile("" ::: "memory"); }
    }
};

struct EpiAB {
    static constexpr bool PERM = true, AFTER_DRAIN = false;
    unsigned char* ws; float* out; const float *ss, *qn, *kn, *bg; int li;
    __device__ __forceinline__ void operator()(const f32x4 (&acc)[2][2][4][2], const Unit& u, int wr, int wc, int fr, int fq) const {
        const int sg = u.pn * 4 + wc, d0 = 8 * fq, row0 = u.pm * BM + wr * 64 + fr;
        unsigned char* w_ = ws; float* o_ = out; LAUNDER(w_); LAUNDER(o_); unsigned char* R_ = w_ + WS_R; const float* rope = (const float*)(w_ + WS_ROPE);
        bf16_t *QA = (bf16_t*)(R_ + R_QA), *KA = (bf16_t*)(R_ + R_KA), *VA = (bf16_t*)(R_ + R_VA), *QB = (bf16_t*)(R_ + R_QB), *KB = (bf16_t*)(R_ + R_KB), *VB = (bf16_t*)(R_ + R_VB), *RB = (bf16_t*)(R_ + R_RB); float* GB = (float*)(R_ + R_GB);
        bf16_t *KAS = (bf16_t*)(w_ + WS_KAS) + (size_t)li * 16 * 160 * 128, *VAS = (bf16_t*)(w_ + WS_VAS) + (size_t)li * 16 * 160 * 128;
        float *oakp = o_ + O_AKP + (size_t)li * 262144, *oavp = o_ + O_AVP + (size_t)li * 262144, *oaks = o_ + O_AKS + (size_t)li * 262144, *oavs = o_ + O_AVS + (size_t)li * 262144;
        float rs8[8];
#pragma unroll
        for (int r8 = 0; r8 < 8; ++r8) rs8[r8] = ss[row0 + (r8 >> 2) * HALF + (r8 & 3) * 16];
#pragma unroll
        for (int ai = 0; ai < 2; ++ai)
#pragma unroll
            for (int m = 0; m < 4; ++m) { const int row = row0 + ai * HALF + m * 16; const float rs = rs8[ai * 4 + m];
                f32x4 v[2][2];
#pragma unroll
                for (int bj = 0; bj < 2; ++bj)
#pragma unroll
                    for (int n = 0; n < 2; ++n) v[bj][n] = acc[ai][bj][m][n] * rs;
                f32x4 w[2][2];
#pragma unroll
                for (int bj = 0; bj < 2; ++bj)
#pragma unroll
                    for (int n = 0; n < 2; ++n) { const int d = 32 * bj + d0 + 4 * n;
                        if (sg < 8) w[bj][n] = *(const f32x4*)(qn + d); else if (sg < 10) w[bj][n] = *(const f32x4*)(kn + d);
                        else if (sg >= 36) w[bj][n] = *(const f32x4*)(bg + 64 * (sg - 36) + d); else w[bj][n] = (f32x4){0.f, 0.f, 0.f, 0.f}; }
                const bool samp = row >= cMP; int b, p, t, pos;
                if (!samp) { b = row / cLP; p = row - b * cLP; t = 0; pos = p; } else { const int s = row - cMP; b = s >> 5; t = s & 31; p = 0; pos = cLP + t; }
                if (sg < 10) {
                    float q = 0.f;
#pragma unroll
                    for (int bj = 0; bj < 2; ++bj)
#pragma unroll
                        for (int n = 0; n < 2; ++n) q += (v[bj][n][0] * v[bj][n][0] + v[bj][n][1] * v[bj][n][1]) + (v[bj][n][2] * v[bj][n][2] + v[bj][n][3] * v[bj][n][3]);
                    q += __shfl_xor(q, 16); q += __shfl_xor(q, 32);
                    const float r = rsqrtf(q * (1.f / 64.f) + 1e-6f);
                    f32x4 o1[2], o2[2];
#pragma unroll
                    for (int n = 0; n < 2; ++n) { const f32x4 c = *(const f32x4*)(rope + (size_t)pos * 64 + d0 + 4 * n), sn = *(const f32x4*)(rope + (size_t)pos * 64 + 32 + d0 + 4 * n);
                        const f32x4 y1 = v[0][n] * r * w[0][n], y2 = v[1][n] * r * w[1][n];
                        o1[n] = y1 * c - y2 * sn; o2[n] = y2 * c + y1 * sn; }
                    if (sg < 8) { const float sc = 0.125f * 1.4426950408889634f;
                        bf16_t* dp = QA + (size_t)row * 512 + 64 * sg + d0; st8bf(dp, o1[0] * sc, o1[1] * sc); st8bf(dp + 32, o2[0] * sc, o2[1] * sc); }
                    else { const int kvh = sg - 8;
                        bf16_t* dp = KA + (size_t)row * 128 + 64 * kvh + d0; st8bf(dp, o1[0], o1[1]); st8bf(dp + 32, o2[0], o2[1]);
                        if (samp) { bf16_t* d2 = KAS + ((size_t)(b * 160 + 128 + t)) * 128 + 64 * kvh + d0; st8bf(d2, o1[0], o1[1]); st8bf(d2 + 32, o2[0], o2[1]);
                            float* f = oaks + ((size_t)((b * 128 + 96 + t) * 2 + kvh)) * 64 + d0; st8f(f, o1[0], o1[1]); st8f(f + 32, o2[0], o2[1]); }
                        else if (p >= cLP - 128) { float* f = oakp + ((size_t)((b * 128 + p - (cLP - 128)) * 2 + kvh)) * 64 + d0; st8f(f, o1[0], o1[1]); st8f(f + 32, o2[0], o2[1]); } }
                } else if (sg < 12) { const int kvh = sg - 10;
                    bf16_t* dp = VA + (size_t)row * 128 + 64 * kvh + d0; st8bf(dp, v[0][0], v[0][1]); st8bf(dp + 32, v[1][0], v[1][1]);
                    if (samp) { bf16_t* d2 = VAS + ((size_t)(b * 160 + 128 + t)) * 128 + 64 * kvh + d0; st8bf(d2, v[0][0], v[0][1]); st8bf(d2 + 32, v[1][0], v[1][1]);
                        float* f = oavs + ((size_t)((b * 128 + 96 + t) * 2 + kvh)) * 64 + d0; st8f(f, v[0][0], v[0][1]); st8f(f + 32, v[1][0], v[1][1]); }
                    else if (p >= cLP - 128) { float* f = oavp + ((size_t)((b * 128 + p - (cLP - 128)) * 2 + kvh)) * 64 + d0; st8f(f, v[0][0], v[0][1]); st8f(f + 32, v[1][0], v[1][1]); }
                } else if (sg < 16) { bf16_t* dp = QB + (size_t)row * 256 + 64 * (sg - 12) + d0; st8bf(dp, v[0][0] * 0.125f, v[0][1] * 0.125f); st8bf(dp + 32, v[1][0] * 0.125f, v[1][1] * 0.125f);
                } else if (sg < 20) { bf16_t* dp = KB + (size_t)row * 256 + 64 * (sg - 16) + d0; st8bf(dp, v[0][0], v[0][1]); st8bf(dp + 32, v[1][0], v[1][1]);
                } else if (sg < 28) { bf16_t* dp = VB + (size_t)row * 512 + 64 * (sg - 20) + d0; st8bf(dp, v[0][0], v[0][1]); st8bf(dp + 32, v[1][0], v[1][1]);
                } else if (sg < 36) { bf16_t* dp = RB + (size_t)row * 512 + 64 * (sg - 28) + d0; st8bf(dp, v[0][0], v[0][1]); st8bf(dp + 32, v[1][0], v[1][1]);
                } else { float* dp = GB + (size_t)row * 256 + 64 * (sg - 36) + d0;
#pragma unroll
                    for (int bj = 0; bj < 2; ++bj) { f32x4 g0, g1;
#pragma unroll
                        for (int i = 0; i < 4; ++i) { g0[i] = logsig(v[bj][0][i] + w[bj][0][i]) * (1.f / 16.f); g1[i] = logsig(v[bj][1][i] + w[bj][1][i]) * (1.f / 16.f); }
                        st8f(dp + 32 * bj, g0, g1); } }
            }
    }
};

struct EpiC {
    static constexpr bool PERM = true, AFTER_DRAIN = false;
    unsigned char* ws; float* out; const float *ss, *qn, *kn, *bf; int li;
    __device__ __forceinline__ void operator()(const f32x4 (&acc)[2][2][4][2], const Unit& u, int wr, int wc, int fr, int fq) const {
        const int sg = u.pn * 4 + wc, d0 = 8 * fq, row0 = u.pm * BM + wr * 64 + fr;
        if (sg > 48) return;
        unsigned char* w_ = ws; float* o_ = out; LAUNDER(w_); LAUNDER(o_); unsigned char* R_ = w_ + WS_R;
        bf16_t *QC = (bf16_t*)(R_ + R_QC), *KC = (bf16_t*)(R_ + R_KC), *VC = (bf16_t*)(R_ + R_VC); float* LF = (float*)(R_ + R_LF);
        bf16_t *KCS = (bf16_t*)(w_ + WS_KCS) + (size_t)li * 16 * 2080 * 1024, *VCS = (bf16_t*)(w_ + WS_VCS) + (size_t)li * 16 * 2080 * 1024; float* LFS = (float*)(w_ + WS_LFS) + (size_t)li * 16 * 2080 * 16;
        float *ockp = o_ + O_CKP + (size_t)li * MP * 1024, *ocvp = o_ + O_CVP + (size_t)li * MP * 1024, *oclfp = o_ + O_CLFP + (size_t)li * MP * 16, *ocks = o_ + O_CKS + (size_t)li * 524288, *ocvs = o_ + O_CVS + (size_t)li * 524288, *oclfs = o_ + O_CLFS + (size_t)li * 8192;
        float rs8[8];
#pragma unroll
        for (int r8 = 0; r8 < 8; ++r8) rs8[r8] = ss[row0 + (r8 >> 2) * HALF + (r8 & 3) * 16];
#pragma unroll
        for (int ai = 0; ai < 2; ++ai)
#pragma unroll
            for (int m = 0; m < 4; ++m) { const int row = row0 + ai * HALF + m * 16; const float rs = rs8[ai * 4 + m];
                f32x4 v[2][2];
#pragma unroll
                for (int bj = 0; bj < 2; ++bj)
#pragma unroll
                    for (int n = 0; n < 2; ++n) v[bj][n] = acc[ai][bj][m][n] * rs;
                f32x4 w[2][2];
#pragma unroll
                for (int bj = 0; bj < 2; ++bj)
#pragma unroll
                    for (int n = 0; n < 2; ++n) { const int d = 32 * bj + d0 + 4 * n;
                        if (sg < 16) w[bj][n] = *(const f32x4*)(qn + d); else if (sg < 32) w[bj][n] = *(const f32x4*)(kn + d);
                        else if (sg == 48 && bj == 0 && fq < 2) w[bj][n] = *(const f32x4*)(bf + d); else w[bj][n] = (f32x4){0.f, 0.f, 0.f, 0.f}; }
                const bool samp = row >= cMP; const int s = row - cMP, b = s >> 5, t = s & 31;
                const size_t srow = (size_t)(b * 2080 + 2048 + t);
                if (sg < 32) {
                    float q = 0.f;
#pragma unroll
                    for (int bj = 0; bj < 2; ++bj)
#pragma unroll
                        for (int n = 0; n < 2; ++n) q += (v[bj][n][0] * v[bj][n][0] + v[bj][n][1] * v[bj][n][1]) + (v[bj][n][2] * v[bj][n][2] + v[bj][n][3] * v[bj][n][3]);
                    q += __shfl_xor(q, 16); q += __shfl_xor(q, 32);
                    const float r = rsqrtf(q * (1.f / 64.f) + 1e-6f);
#pragma unroll
                    for (int bj = 0; bj < 2; ++bj)
#pragma unroll
                        for (int n = 0; n < 2; ++n) v[bj][n] = v[bj][n] * r * w[bj][n];
                    if (sg < 16) { const float sc = 0.125f * 1.4426950408889634f; bf16_t* dp = QC + (size_t)row * 1024 + 64 * sg + d0; st8bf(dp, v[0][0] * sc, v[0][1] * sc); st8bf(dp + 32, v[1][0] * sc, v[1][1] * sc); }
                    else { const int h = sg - 16;
                        if (!samp) { bf16_t* dp = KC + (size_t)row * 1024 + 64 * h + d0; st8bf(dp, v[0][0], v[0][1]); st8bf(dp + 32, v[1][0], v[1][1]);
                            float* f = ockp + (size_t)row * 1024 + 64 * h + d0; st8f(f, v[0][0], v[0][1]); st8f(f + 32, v[1][0], v[1][1]); }
                        else { bf16_t* dp = KCS + srow * 1024 + 64 * h + d0; st8bf(dp, v[0][0], v[0][1]); st8bf(dp + 32, v[1][0], v[1][1]);
                            float* f = ocks + (size_t)s * 1024 + 64 * h + d0; st8f(f, v[0][0], v[0][1]); st8f(f + 32, v[1][0], v[1][1]); } }
                } else if (sg < 48) { const int h = sg - 32;
                    if (!samp) { bf16_t* dp = VC + (size_t)row * 1024 + 64 * h + d0; st8bf(dp, v[0][0], v[0][1]); st8bf(dp + 32, v[1][0], v[1][1]);
                        float* f = ocvp + (size_t)row * 1024 + 64 * h + d0; st8f(f, v[0][0], v[0][1]); st8f(f + 32, v[1][0], v[1][1]); }
                    else { bf16_t* dp = VCS + srow * 1024 + 64 * h + d0; st8bf(dp, v[0][0], v[0][1]); st8bf(dp + 32, v[1][0], v[1][1]);
                        float* f = ocvs + (size_t)s * 1024 + 64 * h + d0; st8f(f, v[0][0], v[0][1]); st8f(f + 32, v[1][0], v[1][1]); }
                } else if (fq < 2) {
                    f32x4 g0, g1;
#pragma unroll
                    for (int i = 0; i < 4; ++i) { g0[i] = logsig(v[0][0][i] + w[0][0][i]); g1[i] = logsig(v[0][1][i] + w[0][1][i]); }
                    if (!samp) { st8f(LF + (size_t)row * 16 + d0, g0, g1); st8f(oclfp + (size_t)row * 16 + d0, g0, g1); }
                    else { st8f(LFS + srow * 16 + d0, g0, g1); st8f(oclfs + (size_t)s * 16 + d0, g0, g1); }
                }
            }
    }
};

struct TailOrder {
    int G, c, klen;
    __host__ __device__ bool next(int i, Unit& u) const { const int L = i * G + c; if (L >= 48) return false; const int tu = L >> 2, q = L & 3; u.pm = 128 + (tu >> 2); u.pn = tu & 3; u.k0 = q * klen; return true; }
    __device__ __forceinline__ void a_ready(const Unit&) const {}
    __device__ __forceinline__ void done(const Unit&) const {}
};
struct EpiPart {
    static constexpr bool PERM = true, AFTER_DRAIN = false;
    unsigned char* ws; int klen;
    __device__ __forceinline__ void operator()(const f32x4 (&acc)[2][2][4][2], const Unit& u, int wr, int wc, int fr, int fq) const {
        const int row0 = (u.pm - 128) * BM + wr * 64 + fr, col0 = u.pn * BM + wc * 32 + 8 * fq, q = u.k0 / klen;
        unsigned char* w_ = ws; LAUNDER(w_); float* PB = (float*)(w_ + WS_PB) + (size_t)q * 768 * 1024;
#pragma unroll
        for (int ai = 0; ai < 2; ++ai)
#pragma unroll
            for (int m = 0; m < 4; ++m) { float* rp = PB + (size_t)(row0 + ai * HALF + m * 16) * 1024 + col0;
#pragma unroll
                for (int bj = 0; bj < 2; ++bj) st8f(rp + bj * HALF, acc[ai][bj][m][0], acc[ai][bj][m][1]);
                asm volatile("" ::: "memory"); }
    }
};
template <class Epi, class Sched, bool ALIGN_EPI = false, bool SP2 = false>
__device__ __forceinline__ void gemm_phase(PG8_LAS unsigned char* lds, const Gemm g, const Sched& S, const Epi& E, int wv) {
    int tid_ = wv * 64 + (int)__builtin_amdgcn_mbcnt_hi(~0u, __builtin_amdgcn_mbcnt_lo(~0u, 0u)); asm volatile("" : "+v"(tid_));
    const int tid = tid_, wid = __builtin_amdgcn_readfirstlane(tid >> 6), lane = tid & 63, wr = wid >> 2, wc = wid & 3, fr = lane & 15, fq = lane >> 4;
    const int K = g.K, nt = g.klen / BK;
    unsigned voffA[2], voffB[2];
#pragma unroll
    for (int i = 0; i < 2; ++i) { int R, C; stage_rc(tid * 16 + i * 8192, R, C); const int Rb = Epi::PERM ? ((R & ~31) + perm32(R & 31)) : R;
        voffA[i] = (unsigned)(R * K + C) * 2u; voffB[i] = (unsigned)(Rb * K + C) * 2u; }
    const size_t kstep = (size_t)(BK * 2);
    const size_t hstep = (size_t)HALF * K * 2;
    const size_t tstep = 2 * hstep;
    const unsigned ldsw = (unsigned)wid * 1024u;
    const int aoff = lds_byte(wr * 64 + fr, fq * 8), boff = lds_byte(wc * 32 + fr, fq * 8);
#define PG8_SA(b, h) (((b) * 2 + (h)) * HTB)
#define PG8_SB(b, h) ((4 + (b) * 2 + (h)) * HTB)
#define PG8_STAGE(bufoff, gbase, voff) do { _Pragma("unroll") for (int _i = 0; _i < 2; ++_i) \
        __builtin_amdgcn_global_load_lds((const unsigned*)((const char*)(gbase) + (voff)[_i]), (PG8_LAS unsigned*)(lds + (bufoff) + ldsw + _i * 8192), 16, 0, 0); } while (0)
#define PG8_LDA(dst, b, h) do { _Pragma("unroll") for (int m = 0; m < 4; ++m) _Pragma("unroll") for (int k = 0; k < 2; ++k) dst[m][k] = *(const PG8_LAS bf16x8*)(lds + PG8_SA(b, h) + aoff + m * 2048 + k * 1024); } while (0)
#define PG8_LDB(dst, b, h) do { _Pragma("unroll") for (int n = 0; n < 2; ++n) _Pragma("unroll") for (int k = 0; k < 2; ++k) dst[n][k] = *(const PG8_LAS bf16x8*)(lds + PG8_SB(b, h) + boff + n * 2048 + k * 1024); } while (0)
#define PG8_MMA(ai, bj, At, Bt) do { __builtin_amdgcn_s_setprio(1); _Pragma("unroll") for (int m = 0; m < 4; ++m) _Pragma("unroll") for (int n = 0; n < 2; ++n) _Pragma("unroll") for (int k = 0; k < 2; ++k) \
        acc[ai][bj][m][n] = __builtin_amdgcn_mfma_f32_16x16x32_bf16(Bt[n][k], At[m][k], acc[ai][bj][m][n], 0, 0, 0); __builtin_amdgcn_s_setprio(0); } while (0)
#define PG8_WAIT_V(n) asm volatile("s_waitcnt vmcnt(" #n ")" ::: "memory")
#define PG8_WAIT_L(n) asm volatile("s_waitcnt lgkmcnt(" #n ")" ::: "memory")
#define PG8_BAR __builtin_amdgcn_s_barrier()
#define PG8_SCHED __builtin_amdgcn_sched_barrier(0)
    Unit cur, nxt; int ui = 0;
    if (!S.next(0, cur)) return;
    f32x4 acc[2][2][4][2];
#pragma unroll
    for (int a = 0; a < 2; ++a)
#pragma unroll
        for (int b = 0; b < 2; ++b)
#pragma unroll
            for (int m = 0; m < 4; ++m)
#pragma unroll
                for (int n = 0; n < 2; ++n) acc[a][b][m][n] = (f32x4){0.f, 0.f, 0.f, 0.f};
    bf16x8 At[4][2], B0[2][2], B1[2][2];
    const char* cA = (const char*)g.A + (size_t)cur.pm * tstep + (size_t)cur.k0 * 2; const char* cB = (const char*)g.Bt + (size_t)cur.pn * tstep + (size_t)cur.k0 * 2;
    S.a_ready(cur);
    if constexpr (SP2) {
        PG8_STAGE(PG8_SB(0, 0), cB, voffB); PG8_STAGE(PG8_SB(0, 1), cB + hstep, voffB); PG8_STAGE(PG8_SA(0, 0), cA, voffA); PG8_STAGE(PG8_SA(0, 1), cA + hstep, voffA);
        if (wr == 1) PG8_BAR;
        PG8_WAIT_V(2); PG8_BAR;
        PG8_STAGE(PG8_SB(1, 0), cB + kstep, voffB); PG8_STAGE(PG8_SA(1, 0), cA + kstep, voffA); PG8_STAGE(PG8_SB(1, 1), cB + hstep + kstep, voffB);
        PG8_WAIT_V(6); PG8_BAR;
    } else {
        PG8_STAGE(PG8_SB(0, 0), cB, voffB); PG8_STAGE(PG8_SA(0, 0), cA, voffA); PG8_STAGE(PG8_SB(0, 1), cB + hstep, voffB); PG8_STAGE(PG8_SA(0, 1), cA + hstep, voffA);
        if (wr == 1) PG8_BAR;
        PG8_WAIT_V(4); PG8_BAR;
        PG8_STAGE(PG8_SB(1, 0), cB + kstep, voffB); PG8_STAGE(PG8_SA(1, 0), cA + kstep, voffA); PG8_STAGE(PG8_SB(1, 1), cB + hstep + kstep, voffB);
        PG8_WAIT_V(6); PG8_BAR;
    }
    for (;;) {
        const bool has_next = S.next(ui + 1, nxt);
        const char* nA = has_next ? (const char*)g.A + (size_t)nxt.pm * tstep + (size_t)nxt.k0 * 2 : cA; const char* nB = has_next ? (const char*)g.Bt + (size_t)nxt.pn * tstep + (size_t)nxt.k0 * 2 : cB;
        for (int t = 0; t < nt; t += 2) {
            const bool last = (t == nt - 2);
            const char* a1 = cA + (size_t)(t + 1) * kstep;
            const char* a2 = last ? nA : cA + (size_t)(t + 2) * kstep; const char* b2 = last ? nB : cB + (size_t)(t + 2) * kstep;
            const char* a3 = a2 + kstep; const char* b3 = b2 + kstep;
            if (last && has_next) S.a_ready(nxt);
            if constexpr (SP2) {
            PG8_LDB(B0, 0, 0); PG8_LDB(B1, 0, 1); PG8_SCHED; PG8_LDA(At, 0, 0); PG8_STAGE(PG8_SA(1, 1), a1 + hstep, voffA);
            PG8_WAIT_V(8); PG8_WAIT_L(0); PG8_BAR; PG8_MMA(0, 0, At, B0); PG8_MMA(0, 1, At, B1); PG8_BAR; PG8_SCHED;
            PG8_LDA(At, 0, 1); PG8_STAGE(PG8_SB(0, 0), b2, voffB); PG8_STAGE(PG8_SB(0, 1), b2 + hstep, voffB); PG8_STAGE(PG8_SA(0, 0), a2, voffA);
            PG8_WAIT_V(8); PG8_WAIT_L(0); PG8_BAR; PG8_MMA(1, 0, At, B0); PG8_MMA(1, 1, At, B1); PG8_BAR; PG8_SCHED;
            PG8_LDB(B0, 1, 0); PG8_LDB(B1, 1, 1); PG8_SCHED; PG8_LDA(At, 1, 0); PG8_STAGE(PG8_SA(0, 1), a2 + hstep, voffA);
            PG8_WAIT_V(8); PG8_WAIT_L(0); PG8_BAR; PG8_MMA(0, 0, At, B0); PG8_MMA(0, 1, At, B1); PG8_BAR; PG8_SCHED;
            PG8_LDA(At, 1, 1); PG8_STAGE(PG8_SB(1, 0), b3, voffB); PG8_STAGE(PG8_SB(1, 1), b3 + hstep, voffB); PG8_STAGE(PG8_SA(1, 0), a3, voffA);
            PG8_WAIT_V(8); PG8_WAIT_L(0); PG8_BAR; PG8_MMA(1, 0, At, B0); PG8_MMA(1, 1, At, B1); PG8_BAR; PG8_SCHED;
            } else {
            PG8_LDB(B0, 0, 0); PG8_SCHED; PG8_LDA(At, 0, 0); PG8_STAGE(PG8_SA(1, 1), a1 + hstep, voffA);
            PG8_WAIT_L(8); PG8_BAR; PG8_WAIT_L(0); PG8_MMA(0, 0, At, B0); PG8_BAR; PG8_SCHED;
            PG8_LDB(B1, 0, 1); PG8_STAGE(PG8_SB(0, 0), b2, voffB);
            PG8_BAR; PG8_WAIT_L(0); PG8_MMA(0, 1, At, B1); PG8_BAR;
            PG8_LDA(At, 0, 1); PG8_STAGE(PG8_SA(0, 0), a2, voffA);
            PG8_BAR; PG8_WAIT_L(0); PG8_MMA(1, 0, At, B0); PG8_BAR; PG8_SCHED;
            PG8_STAGE(PG8_SB(0, 1), b2 + hstep, voffB);
            PG8_WAIT_V(6); PG8_BAR; PG8_MMA(1, 1, At, B1); PG8_BAR;
            PG8_LDB(B0, 1, 0); PG8_SCHED; PG8_LDA(At, 1, 0); PG8_STAGE(PG8_SA(0, 1), a2 + hstep, voffA);
            PG8_WAIT_L(8); PG8_BAR; PG8_WAIT_L(0); PG8_MMA(0, 0, At, B0); PG8_BAR; PG8_SCHED;
            PG8_LDB(B1, 1, 1); PG8_STAGE(PG8_SB(1, 0), b3, voffB);
            PG8_BAR; PG8_WAIT_L(0); PG8_MMA(0, 1, At, B1); PG8_BAR;
            PG8_LDA(At, 1, 1); PG8_STAGE(PG8_SA(1, 0), a3, voffA);
            PG8_BAR; PG8_WAIT_L(0); PG8_MMA(1, 0, At, B0); PG8_BAR; PG8_SCHED;
            PG8_STAGE(PG8_SB(1, 1), b3 + hstep, voffB);
            PG8_WAIT_V(6); PG8_BAR; PG8_MMA(1, 1, At, B1); PG8_BAR;
            }
        }
        if constexpr (ALIGN_EPI) { if (wr == 0) PG8_BAR; }
        if constexpr (!Epi::AFTER_DRAIN) { E(acc, cur, wr, wc, fr, fq); S.done(cur); }
        if (!has_next) break;
#pragma unroll
        for (int a = 0; a < 2; ++a)
#pragma unroll
            for (int b = 0; b < 2; ++b)
#pragma unroll
                for (int m = 0; m < 4; ++m)
#pragma unroll
                    for (int n = 0; n < 2; ++n) acc[a][b][m][n] = (f32x4){0.f, 0.f, 0.f, 0.f};
        cur = nxt; cA = nA; cB = nB; ++ui;
        if constexpr (ALIGN_EPI) { if (wr == 1) PG8_BAR; }
    }
    PG8_WAIT_V(0);
    if constexpr (!ALIGN_EPI) { if (wr == 0) PG8_BAR; }
    PG8_BAR;
    if constexpr (Epi::AFTER_DRAIN) { E.fused(acc, cur, wr, wc, fr, fq, lds, wid, lane); S.done(cur); }
#undef PG8_SA
#undef PG8_SB
#undef PG8_STAGE
#undef PG8_LDA
#undef PG8_LDB
#undef PG8_MMA
#undef PG8_WAIT_V
#undef PG8_WAIT_L
#undef PG8_BAR
#undef PG8_SCHED
}
}
#define LBAR() asm volatile("s_waitcnt lgkmcnt(0)\n\ts_barrier" ::: "memory")
#ifndef PROBE_C2
#define PROBE_C2 1
#endif
#ifndef PROBE_XBAR
#define PROBE_XBAR 0
#endif
#ifndef PROBE_GLA2
#define PROBE_GLA2 0
#endif
#ifndef PROBE_AB2
#define PROBE_AB2 1
#endif
#define LAS __attribute__((address_space(3)))
typedef unsigned short bf16;
typedef short bf16x8 __attribute__((ext_vector_type(8)));
typedef short bf16x4 __attribute__((ext_vector_type(4)));
typedef float f32x4 __attribute__((ext_vector_type(4)));
typedef unsigned u32x4 __attribute__((ext_vector_type(4)));
typedef unsigned u32x2 __attribute__((ext_vector_type(2)));
using pg8::pk;

struct Params { const float* in[26]; float* out; unsigned char* ws; int ph_lo, ph_hi, coop, pad; };

__device__ __forceinline__ float wave_sum(float v) {
#pragma unroll
    for (int o = 1; o < 64; o <<= 1) v += __shfl_xor(v, o);
    return v;
}
typedef short v4i16_t __attribute__((ext_vector_type(4)));
__device__ __forceinline__ bf16x4 trrd(const LAS unsigned char* p) { return __builtin_bit_cast(bf16x4, __builtin_amdgcn_ds_read_tr16_b64_v4i16((LAS v4i16_t*)p)); }
__device__ __forceinline__ f32x4 mfma16(bf16x8 a, bf16x8 b, f32x4 c) { return __builtin_amdgcn_mfma_f32_16x16x32_bf16(a, b, c, 0, 0, 0); }

template <int KIND>
__device__ __forceinline__ void wt_item(const float* W, const float* Wg, const float* gsc, int K, int N, bf16* WT, LAS float* scr, int item, int lane) {
    const int nblk = N / 32, kb = item / nblk, nb = item % nblk, k0 = 64 * kb, n0 = 32 * nb;
    int L0 = n0;
    if (KIND != 0) { const int pn = n0 >> 8, gq = (n0 & 255) >> 5; L0 = (pn << 8) + 32 * (2 * (gq & 3) + (gq >> 2)); }
    const int L = L0 + (lane & 31);
#pragma unroll 16
    for (int i = 0; i < 32; ++i) { const int kk = 2 * i + (lane >> 5), k = k0 + kk; float v;
        if (KIND == 0) v = W[(size_t)k * N + L];
        else if (KIND == 1) { if (L0 < 2304) v = W[(size_t)k * 2320 + L]; else { float s = 0.f; const float* w1 = W + (size_t)k * 2320 + 2304; const float* w2 = Wg + (L - 2304);
#pragma unroll
                for (int r = 0; r < 16; ++r) s += w1[r] * w2[r * 256]; v = s; } }
        else { const int Lc = L < 3088 ? L : 3087; v = W[(size_t)k * 3088 + Lc]; if (L >= 3088) v = 0.f; }
        if (gsc) v *= gsc[k];
        scr[kk * 33 + (lane & 31)] = v; }
    asm volatile("s_waitcnt lgkmcnt(0)" ::: "memory");
    const int c = lane & 7;
#pragma unroll
    for (int j = 0; j < 4; ++j) { const int n = (lane >> 3) + 8 * j; const LAS float* s = scr + (8 * c) * 33 + n;
        u32x4 o; o.x = pk(s[0 * 33], s[1 * 33]); o.y = pk(s[2 * 33], s[3 * 33]); o.z = pk(s[4 * 33], s[5 * 33]); o.w = pk(s[6 * 33], s[7 * 33]);
        *(u32x4*)(WT + (size_t)(n0 + n) * K + k0 + 8 * c) = o; }
    asm volatile("s_waitcnt lgkmcnt(0)" ::: "memory");
}

constexpr int WI_AB = (1024 / 64) * (NAB / 32), WI_C = (1024 / 64) * (NC / 32), WI_O = (1024 / 64) * (1024 / 32), WI_UP = (1024 / 64) * (4096 / 32), WI_DN = (4096 / 64) * (1024 / 32);
constexpr int WI_ALL = 2 * WI_AB + 2 * WI_C + 4 * WI_O + 4 * WI_UP + 4 * WI_DN;
#define WT_DISPATCH(it_) do { int r = (it_); constexpr int I_AB = WI_AB, I_C = WI_C, I_O = WI_O, I_UP = WI_UP, I_DN = WI_DN; \
            if (r < 2 * I_AB) { const int i = r / I_AB; r %= I_AB; wt_item<1>(IN(11) + (size_t)i * 1024 * 2320, IN(15) + (size_t)i * 16 * 256, IN(9) + (size_t)(2 * i) * 1024, 1024, NAB, (bf16*)(ws + WS_WAB) + (size_t)i * NAB * 1024, scr, r, lane); break; } r -= 2 * I_AB; \
            if (r < 2 * I_C) { const int i = r / I_C; r %= I_C; wt_item<2>(IN(19) + (size_t)i * 1024 * 3088, nullptr, IN(9) + (size_t)(2 * i + 1) * 1024, 1024, NC, (bf16*)(ws + WS_WC) + (size_t)i * NC * 1024, scr, r, lane); break; } r -= 2 * I_C; \
            if (r < 4 * I_O) { const int i = r / I_O; r %= I_O; const float* src = (i < 2) ? IN(18) + (size_t)i * 1048576 : IN(23) + (size_t)(i - 2) * 1048576; \
                bf16* dst = (i < 2) ? (bf16*)(ws + WS_WOAB) + (size_t)i * 1048576 : (bf16*)(ws + WS_WOC) + (size_t)(i - 2) * 1048576; wt_item<0>(src, nullptr, nullptr, 1024, 1024, dst, scr, r, lane); break; } r -= 4 * I_O; \
            if (r < 4 * I_UP) { const int l = r / I_UP; r %= I_UP; wt_item<0>(IN(24) + (size_t)l * 4194304, nullptr, IN(10) + (size_t)l * 1024, 1024, 4096, (bf16*)(ws + WS_WUP) + (size_t)l * 4194304, scr, r, lane); break; } r -= 4 * I_UP; \
            { const int l = r / I_DN; r %= I_DN; wt_item<0>(IN(25) + (size_t)l * 4194304, nullptr, nullptr, 4096, 1024, (bf16*)(ws + WS_WDN) + (size_t)l * 4194304, scr, r, lane); } \
    } while (0)
__device__ __forceinline__ void prologue(const Params& P, LAS unsigned char* lds, int z, int wv, int gdim, int bidx) {
#define IN(k) (P.in[(k) + z])
    float* out = P.out + z;
    int tid_ = wv * 64 + (int)__builtin_amdgcn_mbcnt_hi(~0u, __builtin_amdgcn_mbcnt_lo(~0u, 0u)); asm volatile("" : "+v"(tid_)); const int tid = tid_, lane = tid & 63, wave = __builtin_amdgcn_readfirstlane(tid >> 6);
    const int gw = bidx * 8 + wave, NGW = gdim * 8;
    const size_t gt = (size_t)bidx * 512 + tid, NGT = (size_t)gdim * 512;
    unsigned char* ws = P.ws + z;
    LAS float* scr = (LAS float*)(lds + wave * 16384);
    for (int it = gw; it < WI_AB; it += NGW) WT_DISPATCH(it);
    {
        float* X = (float*)(ws + WS_X); bf16* XB = (bf16*)(ws + WS_XB); float* SS = (float*)(ws + WS_SS);
        for (int row0 = gw; row0 < MT; row0 += 4 * NGW) { f32x4 v[4][4];
#pragma unroll
            for (int u = 0; u < 4; ++u) { const int row = row0 + u * NGW; if (row < MT) { const float* src;
                if (row < MP) { const int b = row / LP, p = row - b * LP; src = (p < 16) ? IN(8) + (size_t)p * 1024 : IN(0) + ((size_t)b * 2048 + (p - 16)) * 1024; } else src = IN(1) + (size_t)(row - MP) * 1024;
#pragma unroll
                for (int j = 0; j < 4; ++j) v[u][j] = *(const f32x4*)(src + 256 * j + 4 * lane); } }
#pragma unroll
            for (int u = 0; u < 4; ++u) { const int row = row0 + u * NGW; if (row < MT) { float s = 0.f;
#pragma unroll
                for (int j = 0; j < 4; ++j) { const f32x4 x = v[u][j]; s += (x[0] * x[0] + x[1] * x[1]) + (x[2] * x[2] + x[3] * x[3]);
                    u32x2 w; w.x = pk(x[0], x[1]); w.y = pk(x[2], x[3]); *(u32x2*)(XB + (size_t)row * 1024 + 256 * j + 4 * lane) = w; }
                s = wave_sum(s); if (lane == 0) ((float*)(ws + WS_RS))[row] = rsqrtf(s * (1.f / 1024.f) + 1e-6f); } } }
        if (gt < 16) ((unsigned*)(ws + WS_CTL))[gt] = 0u;
    }
    {
        bf16* KAS = (bf16*)(ws + WS_KAS); bf16* VAS = (bf16*)(ws + WS_VAS);
        for (size_t i = gt; i < (size_t)2 * 16 * 128 * 128; i += NGT) { const size_t ib = i / (128 * 128), rem = i % (128 * 128); const int pos = (int)(rem / 128), c = (int)(rem % 128);
            const float kx = IN(2)[i], vx = IN(3)[i];
            KAS[(ib * 160 + pos) * 128 + c] = (bf16)(pk(kx, 0.f) & 0xffffu); VAS[(ib * 160 + pos) * 128 + c] = (bf16)(pk(vx, 0.f) & 0xffffu);
            if (pos >= 32) { out[O_AKS + (ib * 128 + pos - 32) * 128 + c] = kx; out[O_AVS + (ib * 128 + pos - 32) * 128 + c] = vx; } }
    }
    {
        float* RT = (float*)(ws + WS_ROPE);
        for (size_t i = gt; i < (size_t)2096 * 32; i += NGT) { const int pos = (int)(i >> 5), j = (int)(i & 31);
            const float inv = powf(10000.f, -(float)j / 32.f); const float ang = (float)pos * inv; float sn, cs; sincosf(ang, &sn, &cs);
            RT[(size_t)pos * 64 + j] = cs; RT[(size_t)pos * 64 + 32 + j] = sn; }
    }
}

struct AttnBlk { const bf16* k; const bf16* v; const float* lf; int kld, vld, lfld, klo, khi, t0, t1, q0pos; float qkb; };
struct AttnWave { const bf16* q; bf16* o; int qld, old, ilo, ihi, qpos, active; float sink2; };
constexpr int AT_KS = 0, AT_VT = 8192, AT_CS = 16384, AT_BUF = 16640;
__device__ __forceinline__ int swz(int row, int chunk) { return row * 128 + ((chunk ^ (row & 7)) << 4); }

template <bool FOX>
__device__ __forceinline__ void attn_tile(LAS unsigned char* base, int t, const AttnBlk& B, const AttnWave& W, const bf16x8 (&qf)[2][2], f32x4 (&ot)[4][2], float (&lrun)[2], float (&mrun)[2], const float (&ctq)[2], int lane, int l15, int quad) {
            f32x4 st[4][2];
#pragma unroll
            for (int kb = 0; kb < 4; ++kb) { const bf16x8 k0 = *(const LAS bf16x8*)(base + AT_KS + swz(16 * kb + l15, quad)), k1 = *(const LAS bf16x8*)(base + AT_KS + swz(16 * kb + l15, 4 + quad));
                f32x4 ci = (f32x4){0.f, 0.f, 0.f, 0.f}; if (FOX) ci = *(const LAS f32x4*)(base + AT_CS + (16 * kb + 4 * quad) * 4);
#pragma unroll
                for (int nq = 0; nq < 2; ++nq) { st[kb][nq] = mfma16(k0, qf[nq][0], ci); st[kb][nq] = mfma16(k1, qf[nq][1], st[kb][nq]); } }
            const bool needmask = FOX ? (64 * t + 63 > W.qpos) : (64 * t < B.klo || 64 * t + 64 > B.khi);
            if (needmask) {
#pragma unroll
                for (int kb = 0; kb < 4; ++kb)
#pragma unroll
                    for (int j = 0; j < 4; ++j) { const int kk = 64 * t + 16 * kb + 4 * quad + j; const bool kout = (kk < B.klo) || (kk >= B.khi);
#pragma unroll
                        for (int nq = 0; nq < 2; ++nq) { const int qp = W.qpos + 16 * nq + l15; if (kout || (FOX && kk > qp)) st[kb][nq][j] = -1e30f; } } }
            bf16x8 pf[2][2];
#pragma unroll
            for (int nq = 0; nq < 2; ++nq) {
                if (FOX) {
                    float ps = 0.f;
#pragma unroll
                    for (int kb = 0; kb < 4; ++kb)
#pragma unroll
                        for (int j = 0; j < 4; ++j) { const float p = __builtin_amdgcn_exp2f(st[kb][nq][j] + ctq[nq]); st[kb][nq][j] = p; ps += p; }
                    lrun[nq] += ps;
                } else {
                float mx = st[0][nq][0];
#pragma unroll
                for (int kb = 0; kb < 4; ++kb)
#pragma unroll
                    for (int j = 0; j < 4; ++j) mx = fmaxf(mx, st[kb][nq][j]);
                mx = fmaxf(mx, __shfl_xor(mx, 16)); mx = fmaxf(mx, __shfl_xor(mx, 32));
                const float mn = fmaxf(mrun[nq], mx), al = __builtin_amdgcn_exp2f(mrun[nq] - mn); mrun[nq] = mn; float ps = 0.f;
#pragma unroll
                for (int kb = 0; kb < 4; ++kb)
#pragma unroll
                    for (int j = 0; j < 4; ++j) { const float p = __builtin_amdgcn_exp2f(st[kb][nq][j] - mn); st[kb][nq][j] = p; ps += p; }
                lrun[nq] = lrun[nq] * al + ps;
#pragma unroll
                for (int db = 0; db < 4; ++db) ot[db][nq] *= al;
                }
#pragma unroll
                for (int kh = 0; kh < 2; ++kh) { u32x4 w; w.x = pk(st[2 * kh][nq][0], st[2 * kh][nq][1]); w.y = pk(st[2 * kh][nq][2], st[2 * kh][nq][3]); w.z = pk(st[2 * kh + 1][nq][0], st[2 * kh + 1][nq][1]); w.w = pk(st[2 * kh + 1][nq][2], st[2 * kh + 1][nq][3]);
                    pf[kh][nq] = __builtin_bit_cast(bf16x8, w); } }
#pragma unroll
            for (int db = 0; db < 4; ++db)
#pragma unroll
                for (int kh = 0; kh < 2; ++kh) { const LAS unsigned char* vp = base + AT_VT + swz(32 * kh + 4 * quad + (l15 >> 2), 2 * db + ((lane & 3) >> 1)) + 8 * (lane & 1);
                    const bf16x4 lo = trrd(vp), hi = trrd(vp + 16 * 128);
                    const bf16x8 vf = (bf16x8){lo[0], lo[1], lo[2], lo[3], hi[0], hi[1], hi[2], hi[3]};
#pragma unroll
                    for (int nq = 0; nq < 2; ++nq) ot[db][nq] = mfma16(vf, pf[kh][nq], ot[db][nq]); }
}

template <bool FOX>
__device__ __forceinline__ void attn_unit(LAS unsigned char* lds, const AttnBlk B, const AttnWave W, int wv) {
    int tid_ = wv * 64 + (int)__builtin_amdgcn_mbcnt_hi(~0u, __builtin_amdgcn_mbcnt_lo(~0u, 0u)); asm volatile("" : "+v"(tid_)); const int tid = tid_, lane = tid & 63, wid = __builtin_amdgcn_readfirstlane(tid >> 6), l15 = lane & 15, quad = lane >> 4;
    bf16x8 qf[2][2];
#pragma unroll
    for (int nq = 0; nq < 2; ++nq) { int i = 16 * nq + l15; i = i < W.ilo ? W.ilo : i; i = i >= W.ihi ? W.ihi - 1 : i;
        if (W.active) { const bf16* qp = W.q + (ptrdiff_t)i * W.qld + quad * 8; qf[nq][0] = *(const bf16x8*)qp; qf[nq][1] = *(const bf16x8*)(qp + 32); }
        else { qf[nq][0] = (bf16x8){0, 0, 0, 0, 0, 0, 0, 0}; qf[nq][1] = qf[nq][0]; } }
    float mrun[2] = {-1e30f, -1e30f}, lrun[2] = {0.f, 0.f};
    f32x4 ot[4][2];
#pragma unroll
    for (int a = 0; a < 4; ++a)
#pragma unroll
        for (int b = 0; b < 2; ++b) ot[a][b] = (f32x4){0.f, 0.f, 0.f, 0.f};
    float ctq[2] = {0.f, 0.f};
    if (FOX && W.active) {
#pragma unroll
        for (int nq = 0; nq < 2; ++nq) { int qp = W.qpos + 16 * nq + l15; qp = qp >= B.khi ? B.khi - 1 : qp; ctq[nq] = B.lf[(ptrdiff_t)qp * B.lfld]; } }
    u32x4 kreg, vreg, kreg2, vreg2; float lfreg = 0.f, lfreg2 = 0.f;
#define AT_ISSUE(t, kreg, vreg, lfreg) do { const int kk_ = (t) * 64 + (tid >> 3); int kc_ = kk_ < B.klo ? B.klo : kk_; kc_ = kc_ >= B.khi ? B.khi - 1 : kc_; \
        kreg = *(const u32x4*)(B.k + (ptrdiff_t)kc_ * B.kld + (tid & 7) * 8); vreg = *(const u32x4*)(B.v + (ptrdiff_t)kc_ * B.vld + (tid & 7) * 8); \
        if (FOX && wid == 0) { const int kl_ = (t) * 64 + lane; int kd_ = kl_ < B.klo ? B.klo : kl_; kd_ = kd_ >= B.khi ? B.khi - 1 : kd_; lfreg = (kl_ >= B.klo && kl_ < B.khi) ? B.lf[(ptrdiff_t)kd_ * B.lfld] : 0.f; } } while (0)
#define AT_COMMIT(buf) do { LAS unsigned char* base_ = lds + (buf) * AT_BUF; \
        *(LAS u32x4*)(base_ + AT_KS + swz(tid >> 3, tid & 7)) = kreg; \
        *(LAS u32x4*)(base_ + AT_VT + swz(tid >> 3, tid & 7)) = vreg; \
        if (FOX && wid == 0) { float x_ = lfreg; \
            ((LAS float*)(base_ + AT_CS))[lane] = -x_; } } while (0)
    int tbeg = B.t0;
    if (FOX) {
        int ke = 64 * lane + 63; ke = ke >= B.khi ? B.khi - 1 : ke; const float cend = B.lf[(ptrdiff_t)ke * B.lfld], cq0 = B.lf[(ptrdiff_t)B.q0pos * B.lfld];
        const bool keep = (lane >= B.t1 - 1) || (B.qkb + cq0 - cend >= -160.f);
        const unsigned long long bm = __ballot(keep); tbeg = (int)__ffsll((long long)bm) - 1; tbeg = __builtin_amdgcn_readfirstlane(tbeg); if (tbeg < B.t0) tbeg = B.t0;
    }
#define AT_COMMIT2(buf, kreg, vreg, lfreg) do { LAS unsigned char* base_ = lds + (buf) * AT_BUF; \
        *(LAS u32x4*)(base_ + AT_KS + swz(tid >> 3, tid & 7)) = kreg; \
        *(LAS u32x4*)(base_ + AT_VT + swz(tid >> 3, tid & 7)) = vreg; \
        if (FOX && wid == 0) ((LAS float*)(base_ + AT_CS))[lane] = -lfreg; } while (0)
    AT_ISSUE(tbeg, kreg, vreg, lfreg); AT_COMMIT2(0, kreg, vreg, lfreg);
    AT_ISSUE(tbeg + 1, kreg, vreg, lfreg);
    for (int t = tbeg; t < B.t1; t += 2) {
        LBAR();
        AT_ISSUE(t + 2, kreg2, vreg2, lfreg2);
        if (W.active) attn_tile<FOX>(lds, t, B, W, qf, ot, lrun, mrun, ctq, lane, l15, quad);
        if (t + 1 < B.t1) AT_COMMIT2(1, kreg, vreg, lfreg);
        if (t + 1 >= B.t1) break;
        LBAR();
        AT_ISSUE(t + 3, kreg, vreg, lfreg);
        if (W.active) attn_tile<FOX>(lds + AT_BUF, t + 1, B, W, qf, ot, lrun, mrun, ctq, lane, l15, quad);
        if (t + 2 < B.t1) AT_COMMIT2(0, kreg2, vreg2, lfreg2);
    }
#undef AT_COMMIT2
#undef AT_ISSUE
#undef AT_COMMIT
    if (W.active) {
#pragma unroll
        for (int nq = 0; nq < 2; ++nq) { float lt = lrun[nq]; lt += __shfl_xor(lt, 16); lt += __shfl_xor(lt, 32); float sc;
            if (FOX) sc = 1.f / lt; else { const float mf = fmaxf(mrun[nq], W.sink2), a = __builtin_amdgcn_exp2f(mrun[nq] - mf); lt = lt * a + __builtin_amdgcn_exp2f(W.sink2 - mf); sc = a / lt; }
            const int i = 16 * nq + l15;
            if (i >= W.ilo && i < W.ihi) {
#pragma unroll
                for (int db = 0; db < 4; ++db) { const f32x4 o = ot[db][nq] * sc; u32x2 w; w.x = pk(o[0], o[1]); w.y = pk(o[2], o[3]); *(u32x2*)(W.o + (ptrdiff_t)i * W.old + 16 * db + 4 * quad) = w; } } }
    }
    __syncthreads();
}


struct FoxS { const float *kc, *vc, *lf; const bf16 *kn, *vn; const bf16* q; bf16* o; float qkb; };
__device__ __forceinline__ void fox_sample_unit(LAS unsigned char* lds, const FoxS J, int wv) {
    int tid_ = wv * 64 + (int)__builtin_amdgcn_mbcnt_hi(~0u, __builtin_amdgcn_mbcnt_lo(~0u, 0u)); asm volatile("" : "+v"(tid_)); const int tid = tid_, lane = tid & 63, wid = wv, l15 = lane & 15, quad = lane >> 4;
    const int kb = wid & 3, nq = wid >> 2;
    bf16x8 qf[2];
    { const bf16* qp = J.q + (ptrdiff_t)(16 * nq + l15) * 1024 + quad * 8; qf[0] = *(const bf16x8*)qp; qf[1] = *(const bf16x8*)(qp + 32); }
    float lrun = 0.f; f32x4 ot[4]; const float ctq = J.lf[(size_t)(2048 + 16 * nq + l15) * 16];
#pragma unroll
    for (int a = 0; a < 4; ++a) ot[a] = (f32x4){0.f, 0.f, 0.f, 0.f};
    f32x4 ka_, kb_, va_, vb_; float lfreg = 0.f;
    const int skey = tid >> 3, sch = tid & 7;
#define FS_ISSUE(t) do { if ((t) < 32) { const float* kp_ = J.kc + (size_t)((t) * 64 + skey) * 1024 + sch * 8; const float* vp_ = J.vc + (size_t)((t) * 64 + skey) * 1024 + sch * 8; \
            ka_ = __builtin_nontemporal_load((const f32x4*)kp_); kb_ = __builtin_nontemporal_load((const f32x4*)(kp_ + 4)); va_ = __builtin_nontemporal_load((const f32x4*)vp_); vb_ = __builtin_nontemporal_load((const f32x4*)(vp_ + 4)); \
            if (wid == 0) lfreg = J.lf[(size_t)((t) * 64 + lane) * 16]; } \
        else { const int kr_ = skey < 32 ? skey : 31; ka_ = *(const f32x4*)(J.kn + (size_t)kr_ * 1024 + sch * 8); va_ = *(const f32x4*)(J.vn + (size_t)kr_ * 1024 + sch * 8); \
            if (wid == 0) lfreg = lane < 32 ? J.lf[(size_t)(2048 + lane) * 16] : 0.f; } } while (0)
#define FS_COMMIT(buf, tt) do { LAS unsigned char* base_ = lds + (buf) * AT_BUF; u32x4 kreg, vreg; \
        if ((tt) < 32) { kreg = (u32x4){pk(ka_[0], ka_[1]), pk(ka_[2], ka_[3]), pk(kb_[0], kb_[1]), pk(kb_[2], kb_[3])}; vreg = (u32x4){pk(va_[0], va_[1]), pk(va_[2], va_[3]), pk(vb_[0], vb_[1]), pk(vb_[2], vb_[3])}; } \
        else { kreg = __builtin_bit_cast(u32x4, ka_); vreg = __builtin_bit_cast(u32x4, va_); } \
        *(LAS u32x4*)(base_ + AT_KS + swz(skey, sch)) = kreg; *(LAS u32x4*)(base_ + AT_VT + swz(skey, sch)) = vreg; \
        if (wid == 0) ((LAS float*)(base_ + AT_CS))[lane] = -lfreg; } while (0)
    int tbeg;
    { int ke = 64 * lane + 63; ke = ke > 2079 ? 2079 : ke; const float cend = J.lf[(size_t)ke * 16], cq0 = J.lf[(size_t)2048 * 16];
      const bool keep = (lane >= 32) || (J.qkb + cq0 - cend >= -160.f);
      const unsigned long long bm = __ballot(keep); tbeg = __builtin_amdgcn_readfirstlane((int)__ffsll((long long)bm) - 1); }
    FS_ISSUE(tbeg); FS_COMMIT(0, tbeg);
    for (int t = tbeg; t < 33; ++t) {
        const int buf = (t - tbeg) & 1;
        LBAR();
        if (t + 1 < 33) FS_ISSUE(t + 1);
        {
            LAS unsigned char* base = lds + buf * AT_BUF;
            const bf16x8 k0 = *(const LAS bf16x8*)(base + AT_KS + swz(16 * kb + l15, quad)), k1 = *(const LAS bf16x8*)(base + AT_KS + swz(16 * kb + l15, 4 + quad));
            const f32x4 c = *(const LAS f32x4*)(base + AT_CS + (16 * kb + 4 * quad) * 4);
            f32x4 st = mfma16(k0, qf[0], c); st = mfma16(k1, qf[1], st);
            if (t == 32) {
#pragma unroll
                for (int j = 0; j < 4; ++j) { const int kk = 2048 + 16 * kb + 4 * quad + j; if (kk >= 2080 || kk > 2048 + 16 * nq + l15) st[j] = -1e30f; } }
            float p[4]; float ps = 0.f;
#pragma unroll
            for (int j = 0; j < 4; ++j) { p[j] = __builtin_amdgcn_exp2f(st[j] + ctq); ps += p[j]; }
            lrun += ps;
            u32x4 w; w.x = pk(p[0], p[1]); w.y = pk(p[2], p[3]); w.z = 0u; w.w = 0u; const bf16x8 pf = __builtin_bit_cast(bf16x8, w);
#pragma unroll
            for (int db = 0; db < 4; ++db) { const bf16x4 lo = trrd(base + AT_VT + swz(16 * kb + 4 * quad + (l15 >> 2), 2 * db + ((lane & 3) >> 1)) + 8 * (lane & 1));
                ot[db] = mfma16((bf16x8){lo[0], lo[1], lo[2], lo[3], lo[0], lo[1], lo[2], lo[3]}, pf, ot[db]); }
        }
        if (t + 1 < 33) FS_COMMIT(buf ^ 1, t + 1);
    }
#undef FS_ISSUE
#undef FS_COMMIT
    __syncthreads();
    { float lt = lrun; lt += __shfl_xor(lt, 16); lt += __shfl_xor(lt, 32);
      LAS float* ML = (LAS float*)(lds + 32768); if (quad == 0) ML[wid * 32 + 16 + l15] = lt;
      LAS float* OP = (LAS float*)lds + wid * 1024;
#pragma unroll
      for (int db = 0; db < 4; ++db)
#pragma unroll
          for (int j = 0; j < 4; ++j) OP[(16 * db + 4 * quad + j) * 16 + l15] = ot[db][j]; }
    __syncthreads();
    { const int n2 = tid >> 8, q = (tid >> 4) & 15, dg = tid & 15; const LAS float* ML = (const LAS float*)(lds + 32768);
      float L = 0.f, o[4] = {0.f, 0.f, 0.f, 0.f};
#pragma unroll
      for (int k = 0; k < 4; ++k) { const int w = n2 * 4 + k; L += ML[w * 32 + 16 + q]; const LAS float* OPw = (const LAS float*)lds + w * 1024;
#pragma unroll
          for (int e = 0; e < 4; ++e) o[e] += OPw[(4 * dg + e) * 16 + q]; }
      const float inv = 1.f / L; u32x2 w2; w2.x = pk(o[0] * inv, o[1] * inv); w2.y = pk(o[2] * inv, o[3] * inv);
      *(u32x2*)(J.o + (ptrdiff_t)(16 * n2 + q) * 1024 + 4 * dg) = w2; }
    __syncthreads();
}

struct GlaJob { const bf16 *q, *k, *v, *rb; const float* g; bf16* mix; const float* s0; float* sout; const float* onorm; int nchunks, tlo0, thi; };
constexpr int GL_QE = 0, GL_KE = 9216, GL_K2T = 18432, GL_VT = 27648, GL_ST = 46080, GL_SEG = 82944, GL_BLD = 84992, GL_OB = 85248;

__device__ __forceinline__ void gla_unit(LAS unsigned char* lds, const GlaJob J, int wv) {
    int tid_ = wv * 64 + (int)__builtin_amdgcn_mbcnt_hi(~0u, __builtin_amdgcn_mbcnt_lo(~0u, 0u)); asm volatile("" : "+v"(tid_)); const int tid = tid_, lane = tid & 63, wid = __builtin_amdgcn_readfirstlane(tid >> 6), l15 = lane & 15, quad = lane >> 4;
    float gr[8]; unsigned short qr[8], kr[8]; u32x4 vr[2], rn[2], rc[2];
#define GL_LOAD(c) do { const int lo_ = ((c) == 0) ? J.tlo0 : 0; \
        _Pragma("unroll") for (int tt = 0; tt < 8; ++tt) { const int t_ = 8 * wid + tt; const bool ok_ = t_ >= lo_ && t_ < J.thi; const ptrdiff_t r_ = (ptrdiff_t)(64 * (c) + t_); \
            gr[tt] = ok_ ? J.g[r_ * 256 + lane] : 0.f; qr[tt] = ok_ ? J.q[r_ * 256 + lane] : (unsigned short)0; kr[tt] = ok_ ? J.k[r_ * 256 + lane] : (unsigned short)0; } \
        { const bool ok_ = lane >= lo_ && lane < J.thi; const ptrdiff_t r_ = (ptrdiff_t)(64 * (c) + lane); \
          if (ok_) { vr[0] = *(const u32x4*)(J.v + r_ * 512 + wid * 16); vr[1] = *(const u32x4*)(J.v + r_ * 512 + wid * 16 + 8); } else { vr[0] = (u32x4){0u, 0u, 0u, 0u}; vr[1] = vr[0]; } } \
        { const int t2_ = tid >> 3; const bool ok2_ = t2_ >= lo_ && t2_ < J.thi; const ptrdiff_t r2_ = (ptrdiff_t)(64 * (c) + t2_); \
          if (ok2_) { rn[0] = *(const u32x4*)(J.rb + r2_ * 512 + 16 * (tid & 7)); rn[1] = *(const u32x4*)(J.rb + r2_ * 512 + 16 * (tid & 7) + 8); } else { rn[0] = (u32x4){0u, 0u, 0u, 0u}; rn[1] = rn[0]; } } } while (0)
    GL_LOAD(0);
    f32x4 sacc[4];
#pragma unroll
    for (int mb = 0; mb < 4; ++mb) {
#pragma unroll
        for (int j = 0; j < 4; ++j) sacc[mb][j] = J.s0 ? J.s0[(size_t)(16 * mb + 4 * quad + j) * 128 + 16 * wid + l15] : 0.f;
        u32x2 w; w.x = pk(sacc[mb][0], sacc[mb][1]); w.y = pk(sacc[mb][2], sacc[mb][3]);
        *(LAS u32x2*)(lds + GL_ST + (16 * wid + l15) * 144 + (16 * mb + 4 * quad) * 2) = w; }
    for (int c = 0; c < J.nchunks; ++c) {
        const int cur = c & 1; rc[0] = rn[0]; rc[1] = rn[1];
        float bl[8], qv[8], kv[8]; float run = 0.f;
#pragma unroll
        for (int tt = 0; tt < 8; ++tt) { run += gr[tt]; bl[tt] = run; qv[tt] = __uint_as_float((unsigned)qr[tt] << 16); kv[tt] = __uint_as_float((unsigned)kr[tt] << 16); }
        ((LAS float*)(lds + GL_SEG))[wid * 64 + lane] = run;
        { LAS bf16* vt = (LAS bf16*)(lds + GL_VT) + (wid * 16) * 72 + lane;
#pragma unroll
          for (int h = 0; h < 2; ++h) { const u32x4 x = vr[h]; LAS bf16* p = vt + h * 8 * 72;
              p[0 * 72] = (bf16)(x.x & 0xffffu); p[1 * 72] = (bf16)(x.x >> 16); p[2 * 72] = (bf16)(x.y & 0xffffu); p[3 * 72] = (bf16)(x.y >> 16);
              p[4 * 72] = (bf16)(x.z & 0xffffu); p[5 * 72] = (bf16)(x.z >> 16); p[6 * 72] = (bf16)(x.w & 0xffffu); p[7 * 72] = (bf16)(x.w >> 16); } }
        LBAR();
        float pre = 0.f, tot = 0.f;
#pragma unroll
        for (int s = 0; s < 8; ++s) { const float x = ((const LAS float*)(lds + GL_SEG))[s * 64 + lane]; tot += x; if (s < wid) pre += x; }
        float k2[8];
#pragma unroll
        for (int tt = 0; tt < 8; ++tt) { const float b = pre + bl[tt]; const float eb = __expf(b), enb = __expf(-b);
            ((LAS bf16*)(lds + GL_QE))[(8 * wid + tt) * 72 + lane] = (bf16)(pk(qv[tt] * eb, 0.f) & 0xffffu);
            ((LAS bf16*)(lds + GL_KE))[(8 * wid + tt) * 72 + lane] = (bf16)(pk(kv[tt] * enb, 0.f) & 0xffffu);
            k2[tt] = kv[tt] * __expf(tot - b); }
        { u32x4 w; w.x = pk(k2[0], k2[1]); w.y = pk(k2[2], k2[3]); w.z = pk(k2[4], k2[5]); w.w = pk(k2[6], k2[7]); *(LAS u32x4*)(lds + GL_K2T + lane * 144 + wid * 16) = w; }
        if (wid == 0) ((LAS float*)(lds + GL_BLD))[lane] = __expf(tot);
        if (c + 1 < J.nchunks) GL_LOAD(c + 1);
        LBAR();
        {
            const int tb = wid & 3, half = wid >> 2;
            bf16x8 qb[2];
            qb[0] = *(const LAS bf16x8*)(lds + GL_QE + (16 * tb + l15) * 144 + quad * 16); qb[1] = *(const LAS bf16x8*)(lds + GL_QE + (16 * tb + l15) * 144 + 64 + quad * 16);
            f32x4 at[4];
#pragma unroll
            for (int sb = 0; sb < 4; ++sb) { at[sb] = (f32x4){0.f, 0.f, 0.f, 0.f};
                if (sb <= tb) { const bf16x8 a0 = *(const LAS bf16x8*)(lds + GL_KE + (16 * sb + l15) * 144 + quad * 16), a1 = *(const LAS bf16x8*)(lds + GL_KE + (16 * sb + l15) * 144 + 64 + quad * 16);
                    at[sb] = mfma16(a0, qb[0], at[sb]); at[sb] = mfma16(a1, qb[1], at[sb]);
                    if (sb == tb) {
#pragma unroll
                        for (int j = 0; j < 4; ++j) if (4 * quad + j > l15) at[sb][j] = 0.f; } } }
            bf16x8 pf[2];
#pragma unroll
            for (int kh = 0; kh < 2; ++kh) { u32x4 w; w.x = pk(at[2 * kh][0], at[2 * kh][1]); w.y = pk(at[2 * kh][2], at[2 * kh][3]); w.z = pk(at[2 * kh + 1][0], at[2 * kh + 1][1]); w.w = pk(at[2 * kh + 1][2], at[2 * kh + 1][3]); pf[kh] = __builtin_bit_cast(bf16x8, w); }
#pragma unroll
            for (int dvb = 0; dvb < 4; ++dvb) { const int dvrow = 16 * (4 * half + dvb) + l15; f32x4 oacc = (f32x4){0.f, 0.f, 0.f, 0.f};
#pragma unroll
                for (int kh = 0; kh < 2; ++kh) if (2 * kh <= tb) { const LAS unsigned char* vp = lds + GL_VT + dvrow * 144 + (32 * kh + 4 * quad) * 2;
                    const bf16x4 lo = *(const LAS bf16x4*)vp, hi = *(const LAS bf16x4*)(vp + 32);
                    oacc = mfma16((bf16x8){lo[0], lo[1], lo[2], lo[3], hi[0], hi[1], hi[2], hi[3]}, pf[kh], oacc); }
#pragma unroll
                for (int ks = 0; ks < 2; ++ks) { const bf16x8 sf = *(const LAS bf16x8*)(lds + GL_ST + cur * 18432 + dvrow * 144 + ks * 64 + quad * 16); oacc = mfma16(sf, qb[ks], oacc); }
                *(LAS f32x4*)(lds + GL_OB + ((16 * tb + l15) * 132 + 16 * (4 * half + dvb) + 4 * quad) * 4) = oacc; }
#pragma unroll
            for (int mb = 0; mb < 4; ++mb) { const f32x4 d = *(const LAS f32x4*)(lds + GL_BLD + (16 * mb + 4 * quad) * 4); sacc[mb] *= d;
#pragma unroll
                for (int ks = 0; ks < 2; ++ks) { const bf16x8 a = *(const LAS bf16x8*)(lds + GL_K2T + (16 * mb + l15) * 144 + ks * 64 + quad * 16), bfr = *(const LAS bf16x8*)(lds + GL_VT + (16 * wid + l15) * 144 + ks * 64 + quad * 16);
                    sacc[mb] = mfma16(a, bfr, sacc[mb]); }
                u32x2 w; w.x = pk(sacc[mb][0], sacc[mb][1]); w.y = pk(sacc[mb][2], sacc[mb][3]);
                *(LAS u32x2*)(lds + GL_ST + (cur ^ 1) * 18432 + (16 * wid + l15) * 144 + (16 * mb + 4 * quad) * 2) = w; }
        }
        LBAR();
        { const int t = tid >> 3, grp = tid & 7; const int lo = (c == 0) ? J.tlo0 : 0;
          f32x4 o4[4]; float q = 0.f;
#pragma unroll
          for (int i = 0; i < 4; ++i) { o4[i] = *(const LAS f32x4*)(lds + GL_OB + (t * 132 + 16 * grp + 4 * i) * 4); q += (o4[i][0] * o4[i][0] + o4[i][1] * o4[i][1]) + (o4[i][2] * o4[i][2] + o4[i][3] * o4[i][3]); }
          q += __shfl_xor(q, 1); q += __shfl_xor(q, 2); q += __shfl_xor(q, 4);
          if (t >= lo && t < J.thi) { const float r = rsqrtf(q * (1.f / 128.f) + 1e-6f); const ptrdiff_t row = (ptrdiff_t)(64 * c + t);
              const u32x4 r0 = rc[0], r1 = rc[1];
              const unsigned rw[8] = {r0.x, r0.y, r0.z, r0.w, r1.x, r1.y, r1.z, r1.w}; unsigned ow[8];
#pragma unroll
              for (int i = 0; i < 4; ++i) { const f32x4 on = *(const f32x4*)(J.onorm + 16 * grp + 4 * i); float y[4];
#pragma unroll
                  for (int e = 0; e < 4; ++e) { const unsigned wv = rw[2 * i + (e >> 1)]; const float rbv = __uint_as_float((e & 1) ? (wv & 0xffff0000u) : (wv << 16));
                      const float sl = rbv / (1.f + __expf(-rbv)); y[e] = o4[i][e] * r * on[e] * sl; }
                  ow[2 * i] = pk(y[0], y[1]); ow[2 * i + 1] = pk(y[2], y[3]); }
              *(u32x4*)(J.mix + row * 1024 + 16 * grp) = (u32x4){ow[0], ow[1], ow[2], ow[3]}; *(u32x4*)(J.mix + row * 1024 + 16 * grp + 8) = (u32x4){ow[4], ow[5], ow[6], ow[7]}; } }
    }
#undef GL_LOAD
#pragma unroll
    for (int mb = 0; mb < 4; ++mb)
#pragma unroll
        for (int j = 0; j < 4; ++j) J.sout[(size_t)(16 * mb + 4 * quad + j) * 128 + 16 * wid + l15] = sacc[mb][j];
    __syncthreads();
}

__device__ __forceinline__ int next_item(unsigned* ctr, LAS unsigned char* lds, int wv) {
    __syncthreads();
    if (wv == 0 && __builtin_amdgcn_mbcnt_hi(~0u, __builtin_amdgcn_mbcnt_lo(~0u, 0u)) == 0) *(LAS int*)(lds + LDS_SLOT) = (int)atomicAdd(ctr, 1u);
    __syncthreads();
    return *(const LAS int*)(lds + LDS_SLOT);
}

__device__ __forceinline__ void mixer_ab(const Params& P, LAS unsigned char* lds, int iraw, int z, int wv) {
    unsigned* ctr = (unsigned*)(P.ws + z + WS_CTL) + iraw; const int i = iraw & 7;
    const int wid = wv;
    constexpr int N_GP = 64, N_GS = 64, N_SP = 16 * 33 * 2, N_SS = 32, N_ALL = N_GP + N_GS + N_SP + N_SS;
    for (;;) {
        int it = next_item(ctr, lds, wv);
        if (it >= N_ALL * PROBE_AB2) break;
        if (it >= N_ALL) it -= N_ALL;
        unsigned lz_ = 0u; asm volatile("" : "+s"(lz_)); unsigned char* ws = P.ws + z + lz_; float* out = P.out + z + lz_; unsigned char* R = ws + WS_R;
        const bf16 *QA = (const bf16*)(R + R_QA), *KA = (const bf16*)(R + R_KA), *VA = (const bf16*)(R + R_VA), *QB = (const bf16*)(R + R_QB), *KB = (const bf16*)(R + R_KB), *VB = (const bf16*)(R + R_VB), *RB = (const bf16*)(R + R_RB);
        const float* GB = (const float*)(R + R_GB); bf16* MIX = (bf16*)(ws + WS_MIX);
        const bf16* KAS = (const bf16*)(ws + WS_KAS) + (size_t)i * 16 * 160 * 128; const bf16* VAS = (const bf16*)(ws + WS_VAS) + (size_t)i * 16 * 160 * 128;
        if (it < N_GP + N_GS) {
            const bool samp = it >= N_GP; const int u = samp ? it - N_GP : it, b = u >> 2, hb = u & 3;
            const ptrdiff_t r0 = samp ? (ptrdiff_t)(MP + b * 32) : (ptrdiff_t)(b * LP - 48);
            GlaJob J; J.q = QB + r0 * 256 + hb * 64; J.k = KB + r0 * 256 + hb * 64; J.g = GB + r0 * 256 + hb * 64; J.v = VB + r0 * 512 + hb * 128; J.rb = RB + r0 * 512 + hb * 128;
            J.mix = MIX + r0 * 1024 + 512 + hb * 128; J.onorm = IN(17) + (size_t)i * 128;
            J.s0 = samp ? IN(4) + ((size_t)(i * 16 + b) * 4 + hb) * 8192 : nullptr;
            J.sout = out + (samp ? O_BS : O_BP) + ((size_t)(i * 16 + b) * 4 + hb) * 8192;
            J.nchunks = samp ? 1 : 33; J.tlo0 = samp ? 0 : 48; J.thi = samp ? 32 : 64;
            for (int rr = 0; rr < ((PROBE_GLA2 && !samp) ? 2 : 1); ++rr) gla_unit(lds, J, wv);
        } else if (it < N_GP + N_GS + N_SP) {
            const int u = it - N_GP - N_GS, kvh = u & 1, c = (u >> 1) % 33, b = (u >> 1) / 33;
            const ptrdiff_t rq = (ptrdiff_t)b * LP + 64 * c - 48, rk = (ptrdiff_t)b * LP + 64 * (c - 2) - 48;
            AttnBlk B; B.k = KA + rk * 128 + kvh * 64; B.v = VA + rk * 128 + kvh * 64; B.lf = nullptr; B.kld = 128; B.vld = 128; B.lfld = 0; B.q0pos = 0; B.qkb = 0.f;
            B.klo = 48 - 64 * (c - 2); if (B.klo < 0) B.klo = 0; B.khi = 192; B.t0 = B.klo >> 6; B.t1 = 3;
            const int g = wid >> 1, hf = wid & 1, head = kvh * 4 + g;
            AttnWave W; W.q = QA + (rq + 32 * hf) * 512 + head * 64; W.o = MIX + (rq + 32 * hf) * 1024 + head * 64; W.qld = 512; W.old = 1024;
            W.ilo = (c == 0) ? (48 - 32 * hf) : 0; if (W.ilo < 0) W.ilo = 0; W.ihi = 32; W.active = W.ilo < 32; if (!W.active) { W.ilo = 0; }
            W.qpos = 0; W.sink2 = IN(14)[i * 8 + head] * LOG2E;
            attn_unit<false>(lds, B, W, wv);
        } else {
            const int u = it - N_GP - N_GS - N_SP, kvh = u & 1, b = u >> 1;
            AttnBlk B; B.k = KAS + (size_t)b * 160 * 128 + kvh * 64; B.v = VAS + (size_t)b * 160 * 128 + kvh * 64; B.lf = nullptr; B.kld = 128; B.vld = 128; B.lfld = 0; B.q0pos = 0; B.qkb = 0.f; B.klo = 0; B.khi = 160; B.t0 = 0; B.t1 = 3;
            const int g = wid & 3, head = kvh * 4 + g; const ptrdiff_t rq = (ptrdiff_t)MP + b * 32;
            AttnWave W; W.q = QA + rq * 512 + head * 64; W.o = MIX + rq * 1024 + head * 64; W.qld = 512; W.old = 1024; W.ilo = 0; W.ihi = 32; W.active = wid < 4; W.qpos = 0; W.sink2 = IN(14)[i * 8 + head] * LOG2E;
            attn_unit<false>(lds, B, W, wv);
        }
    }
    if (iraw == 0) {
        unsigned char* ws = P.ws + z; unsigned* ctr2 = (unsigned*)(ws + WS_CTL) + 6; const int lane = (int)__builtin_amdgcn_mbcnt_hi(~0u, __builtin_amdgcn_mbcnt_lo(~0u, 0u));
        LAS float* scr = (LAS float*)(lds + wv * 16384);
        for (;;) { const int blk = next_item(ctr2, lds, wv); const int it = WI_AB + blk * 8 + wv; if (WI_AB + blk * 8 >= WI_ALL) break; if (it < WI_ALL) WT_DISPATCH(it); }
    }
}


__device__ __forceinline__ void fox_cumsum(unsigned char* ws, const float* cache_lf, LAS unsigned char* lds, int i, int wv, int gdim, int bidx) {
    const int lane = (int)__builtin_amdgcn_mbcnt_hi(~0u, __builtin_amdgcn_mbcnt_lo(~0u, 0u)), tid = wv * 64 + lane;
    LAS float* arr = (LAS float*)lds;
    for (int u = bidx; u < 32; u += gdim) {
        const bool samp = u >= 16; const int b = samp ? u - 16 : u, N = samp ? 2080 : LP;
        float* dst = samp ? (float*)(ws + WS_LFS) + ((size_t)i * 16 + b) * 2080 * 16 : (float*)(ws + WS_R + R_LF) + (size_t)b * LP * 16;
        const float* csrc = cache_lf + ((size_t)i * 16 + b) * 2048 * 16;
        __syncthreads();
        for (int e = tid; e < N * 16; e += 512) { const int pos = e >> 4, h = e & 15; arr[pos * 17 + h] = (samp && pos < 2048) ? csrc[e] : dst[e]; }
        __syncthreads();
#pragma unroll 1
        for (int hh = 0; hh < 2; ++hh) { const int h = 2 * wv + hh; float carry = 0.f;
            for (int p0 = 0; p0 < N; p0 += 64) { const int pos = p0 + lane; float x = pos < N ? arr[pos * 17 + h] : 0.f;
#pragma unroll
                for (int o = 1; o < 64; o <<= 1) { const float y = __shfl_up(x, o); if (lane >= o) x += y; }
                if (pos < N) arr[pos * 17 + h] = (carry + x) * LOG2E; carry += __shfl(x, 63); } }
        __syncthreads();
        for (int e = tid; e < N * 16; e += 512) dst[e] = arr[(e >> 4) * 17 + (e & 15)];
    }
    __syncthreads();
}

__device__ __forceinline__ void mixer_c(const Params& P, LAS unsigned char* lds, int iraw, int z, int wv) {
    unsigned* ctr = (unsigned*)(P.ws + z + WS_CTL) + 2 + iraw; const int i = iraw & 7;
    const int wid = wv;
    constexpr int N_P = 9 * 256, N_ALL = N_P + 256;
    float qkb;
    { const int ln = (int)__builtin_amdgcn_mbcnt_hi(~0u, __builtin_amdgcn_mbcnt_lo(~0u, 0u)); float mq = fabsf(IN(21)[i * 64 + ln]), mk = fabsf(IN(22)[i * 64 + ln]);
#pragma unroll
      for (int o = 1; o < 64; o <<= 1) { mq = fmaxf(mq, __shfl_xor(mq, o)); mk = fmaxf(mk, __shfl_xor(mk, o)); }
      qkb = 8.f * LOG2E * mq * mk * 1.02f + 2.f; }
    for (;;) {
        int it = next_item(ctr, lds, wv);
        if (it >= N_ALL * PROBE_C2) break;
        if (it >= N_ALL) it -= N_ALL;
        unsigned lz_ = 0u; asm volatile("" : "+s"(lz_)); unsigned char* ws = P.ws + z + lz_; unsigned char* R = ws + WS_R;
        const bf16 *QC = (const bf16*)(R + R_QC), *KC = (const bf16*)(R + R_KC), *VC = (const bf16*)(R + R_VC); const float* LF = (const float*)(R + R_LF);
        const bf16* KCS = (const bf16*)(ws + WS_KCS) + (size_t)i * 16 * 2080 * 1024; const bf16* VCS = (const bf16*)(ws + WS_VCS) + (size_t)i * 16 * 2080 * 1024; const float* LFS = (const float*)(ws + WS_LFS) + (size_t)i * 16 * 2080 * 16;
        bf16* MIX = (bf16*)(ws + WS_MIX);
        AttnBlk B; AttnWave W;
        if (it < N_P) {
            const int kb = 8 - it / 256, bh = it % 256, b = bh >> 4, h = bh & 15;
            const int q0 = (kb == 0) ? 0 : 16 + 256 * (kb - 1), nst = (kb == 0) ? 16 : 256;
            const ptrdiff_t rb = (ptrdiff_t)b * LP;
            B.k = KC + rb * 1024 + h * 64; B.v = VC + rb * 1024 + h * 64; B.lf = LF + rb * 16 + h; B.kld = 1024; B.vld = 1024; B.lfld = 16; B.klo = 0; B.khi = LP; B.t0 = 0; B.q0pos = q0; B.qkb = qkb;
            B.t1 = (q0 + nst + 63) >> 6;
            W.q = QC + (rb + q0 + 32 * wid) * 1024 + h * 64; W.o = MIX + (rb + q0 + 32 * wid) * 1024 + h * 64; W.qld = 1024; W.old = 1024;
            W.ilo = 0; W.ihi = nst - 32 * wid; if (W.ihi > 32) W.ihi = 32; W.active = W.ihi > 0; if (!W.active) W.ihi = 1; W.qpos = q0 + 32 * wid; W.sink2 = 0.f;
        } else {
            const int bh = it - N_P, b = bh >> 4, h = bh & 15; const size_t ib = (size_t)i * 16 + b;
            FoxS J; J.kc = IN(5) + (ib * 2048 * 16 + h) * 64; J.vc = IN(6) + (ib * 2048 * 16 + h) * 64; J.lf = LFS + (size_t)b * 2080 * 16 + h;
            J.kn = KCS + ((size_t)b * 2080 + 2048) * 1024 + h * 64; J.vn = VCS + ((size_t)b * 2080 + 2048) * 1024 + h * 64;
            J.q = QC + ((size_t)MP + b * 32) * 1024 + h * 64; J.o = MIX + ((size_t)MP + b * 32) * 1024 + h * 64; J.qkb = qkb;
            fox_sample_unit(lds, J, wv);
            continue;
        }
        attn_unit<true>(lds, B, W, wv);
    }
}

#define XB_TMO      128
#define XB_XCNT(j)  (256  + 64 * (j))
#define XB_XSUB(j)  (1280 + 64 * (j))
#define XB_XGEN(j)  (2304 + 64 * (j))
#define XB_TOP      3328
#define XB_TOPGEN   3392
#define XCD_BAR_WORDS 3456
#define XB_SPIN_CAP (1u << 18)

__device__ __forceinline__ unsigned xb_ld(unsigned* p)              { return __hip_atomic_load(p, __ATOMIC_RELAXED, __HIP_MEMORY_SCOPE_AGENT); }
__device__ __forceinline__ unsigned xb_add(unsigned* p, unsigned v) { return __hip_atomic_fetch_add(p, v, __ATOMIC_RELAXED, __HIP_MEMORY_SCOPE_AGENT); }
__device__ __forceinline__ unsigned xb_xcc_id() { return (unsigned)__builtin_amdgcn_s_getreg((3 << 11) | 20) & 0xFu; }
#define XB_SPIN(cond, bar) do { unsigned _sp = 0; while (cond) { __builtin_amdgcn_s_sleep(1); \
    if ((++_sp & 255u) == 0u) { if (xb_ld(&(bar)[XB_TMO])) break; if (_sp > XB_SPIN_CAP) { atomicAdd(&(bar)[XB_TMO], 1u); break; } } } } while (0)

struct XcdBarrier {
    unsigned* bar; unsigned x;
    volatile LAS unsigned* st;
};

__device__ __forceinline__ XcdBarrier xcd_barrier_post(unsigned* bar, volatile LAS unsigned* st, int wv) {
    const bool leader = (wv == 0) && (__builtin_amdgcn_mbcnt_hi(~0u, __builtin_amdgcn_mbcnt_lo(~0u, 0u)) == 0u);
    XcdBarrier b; b.bar = bar; b.x = xb_xcc_id(); b.st = st;
    if (leader) (void)xb_add(&bar[XB_XCNT(b.x)], 1u);
    return b;
}
__device__ __forceinline__ void xcd_barrier_complete(unsigned* bar, unsigned x, unsigned& nloc, unsigned& nx) {
    const unsigned G = gridDim.x * gridDim.y * gridDim.z;
    unsigned sum, cnt, mine, sp = 0u;
    for (;;) {
        sum = 0u; cnt = 0u; mine = 0u;
#pragma unroll
        for (unsigned j = 0; j < 16; ++j) { const unsigned c = xb_ld(&bar[XB_XCNT(j)]); sum += c; cnt += (c > 0u) ? 1u : 0u; mine = (j == x) ? c : mine; }
        if (sum == G) break;
        __builtin_amdgcn_s_sleep(1);
        if ((++sp & 255u) == 0u) { if (xb_ld(&bar[XB_TMO])) break; if (sp > XB_SPIN_CAP) { atomicAdd(&bar[XB_TMO], 1u); break; } }
    }
    nloc = mine > 0u ? mine : 1u; nx = cnt > 0u ? cnt : 1u;
}

__device__ __forceinline__ void xcd_barrier(const XcdBarrier& b, int wv) {
    const bool leader = (wv == 0) && (__builtin_amdgcn_mbcnt_hi(~0u, __builtin_amdgcn_mbcnt_lo(~0u, 0u)) == 0u);
    asm volatile("s_waitcnt vmcnt(0)" ::: "memory");
    __syncthreads();
    if (leader) {
        unsigned* bar = b.bar; const unsigned bx = b.x;
        __builtin_amdgcn_s_waitcnt(0);
        unsigned nloc = b.st[0], nx = b.st[1];
        if (nloc == 0u) { xcd_barrier_complete(bar, bx, nloc, nx); b.st[0] = nloc; b.st[1] = nx; }
        const unsigned old = xb_add(&bar[XB_XSUB(bx)], 1u);
        const unsigned gen = old / nloc;
        if (old + 1u == (gen + 1u) * nloc) {
            __builtin_amdgcn_fence(__ATOMIC_RELEASE, "agent");
            asm volatile("s_waitcnt vmcnt(0)" ::: "memory");
            const unsigned og = xb_add(&bar[XB_TOP], 1u);
            const unsigned tg = og / nx;
            if (og + 1u == (tg + 1u) * nx) xb_add(&bar[XB_TOPGEN], 1u);
            else XB_SPIN(xb_ld(&bar[XB_TOPGEN]) == tg, bar);
            __builtin_amdgcn_fence(__ATOMIC_ACQUIRE, "agent");
            xb_add(&bar[XB_XGEN(bx)], 1u);
            asm volatile("s_waitcnt vmcnt(0)" ::: "memory");
        } else {
            XB_SPIN(xb_ld(&bar[XB_XGEN(bx)]) == gen, bar);
            __builtin_amdgcn_fence(__ATOMIC_ACQUIRE, "agent");
            asm volatile("s_waitcnt vmcnt(0)" ::: "memory");
        }
    }
    __syncthreads();
}

__device__ __forceinline__ void tail_reduce(unsigned char* ws, float* out, float* ssout, float* rsout, bool fin, int wv, int gdim, int bidx) {
    const int lane = (int)__builtin_amdgcn_mbcnt_hi(~0u, __builtin_amdgcn_mbcnt_lo(~0u, 0u));
    float* X = (float*)(ws + WS_X); bf16* XB = (bf16*)(ws + WS_XB); const float* PB = (const float*)(ws + WS_PB);
    for (int r = bidx * 8 + wv; r < 768; r += gdim * 8) { const int row = 32768 + r; float part = 0.f;
        float* op = nullptr; bool ok = true;
        if (fin) { if (row < MP) { const int b = row / LP, p = row - b * LP; ok = p >= 16; op = out + O_YP + ((size_t)(b * 2048 + p - 16)) * 1024; } else op = out + O_YS + (size_t)(row - MP) * 1024; }
#pragma unroll
        for (int k = 0; k < 4; ++k) { const int col = 16 * lane + 4 * k; const u32x2 xr = *(const u32x2*)(XB + (size_t)row * 1024 + col);
            f32x4 x = (f32x4){__uint_as_float(xr.x << 16), __uint_as_float(xr.x & 0xffff0000u), __uint_as_float(xr.y << 16), __uint_as_float(xr.y & 0xffff0000u)};
#pragma unroll
            for (int q = 0; q < 4; ++q) x += *(const f32x4*)(PB + ((size_t)q * 768 + r) * 1024 + col);
            if (fin) { if (ok) *(f32x4*)(op + col) = x; }
            else { u32x2 w; w.x = pk(x[0], x[1]); w.y = pk(x[2], x[3]); *(u32x2*)(XB + (size_t)row * 1024 + col) = w;
                part += (x[0] * x[0] + x[1] * x[1]) + (x[2] * x[2] + x[3] * x[3]); } }
        if (!fin && ssout) { part = wave_sum(part); if (lane == 0) rsout[row] = rsqrtf(part * (1.f / 1024.f) + 1e-6f); } }
    if (!fin && ssout) for (int row = bidx * 512 + wv * 64 + lane; row < 32768; row += gdim * 512) { const f32x4* p = (const f32x4*)(ssout + (size_t)row * 16); const f32x4 a = p[0], b = p[1], c = p[2], d = p[3];
        const float s = (((a[0] + a[1]) + (a[2] + a[3])) + ((b[0] + b[1]) + (b[2] + b[3]))) + (((c[0] + c[1]) + (c[2] + c[3])) + ((d[0] + d[1]) + (d[2] + d[3]))); rsout[row] = rsqrtf(s * (1.f / 1024.f) + 1e-6f); }
}
#ifndef PROBE_REP
#define PROBE_REP (-1)
#endif
__global__ void __launch_bounds__(512, 2) hybrid_fwd(Params P) {
    extern __shared__ __attribute__((aligned(16))) unsigned char lds_raw[];
    LAS unsigned char* lds = (LAS unsigned char*)lds_raw;
    if (P.coop == 2) { __threadfence(); cg::this_grid().sync(); }
    const int wv = __builtin_amdgcn_readfirstlane((int)(threadIdx.x >> 6));
    if (P.coop) { volatile LAS unsigned* st = (volatile LAS unsigned*)(lds + LDS_SLOT + 16); if (wv == 0) { st[0] = 0u; st[1] = 0u; } __syncthreads(); (void)xcd_barrier_post((unsigned*)(P.ws + WS_BAR), st, wv); }
    for (int ph = P.ph_lo; ph < P.ph_hi; ++ph) {
        int z; asm volatile("s_mov_b32 %0, 0" : "=s"(z));
        unsigned char* ws = P.ws + z; float* out = P.out + z; const int gdim = (int)gridDim.x + z, bidx = (int)blockIdx.x + z;
        unsigned char* R = ws + WS_R; float* SS = (float*)(ws + WS_SS);
#define IN(k) (P.in[(k) + z])
        int nrep = 1;
        { const int l_ = (ph - 1) / 5, k_ = (ph - 1) % 5; const bool ev_ = (l_ & 1) == 0;
          if (PROBE_REP == 100 && ph == 0) nrep = 2;
          if (ph > 0 && ((PROBE_REP == 0 && k_ == 0) || (PROBE_REP == 1 && k_ == 1 && ev_) || (PROBE_REP == 11 && k_ == 1 && !ev_) || (PROBE_REP == 3 && k_ == 3) || (PROBE_REP == 4 && k_ == 4) || (PROBE_REP == 2 && k_ == 2))) nrep = 2; }
        for (int rep = 0; rep < nrep; ++rep) {
        if (ph == 0) {
#ifndef NO_PRO
            prologue(P, lds, z, wv, gdim, bidx);
#endif
        } else {
            const int l = (ph - 1) / 5, kind = (ph - 1) % 5, i = l >> 1; const bool even = (l & 1) == 0;
            if (kind == 0) {
                if (even) {
#ifndef NO_AB
                    pg8::Gemm g{(const pg8::bf16_t*)(ws + WS_XB), (const pg8::bf16_t*)(ws + WS_WAB) + (size_t)i * NAB * 1024, MT, NAB, 1024, 1024};
                    pg8::StaticOrder S; S.init(MT, NAB, gdim, bidx);
                    pg8::EpiAB E{ws, out, (const float*)(ws + WS_RS) + (size_t)(2 * l) * MT, IN(12) + i * 64, IN(13) + i * 64, IN(16) + i * 256, i};
                    pg8::gemm_phase<pg8::EpiAB, pg8::StaticOrder, true, true>(lds, g, S, E, wv);
#endif
                } else {
#ifndef NO_C
                    pg8::Gemm g{(const pg8::bf16_t*)(ws + WS_XB), (const pg8::bf16_t*)(ws + WS_WC) + (size_t)i * NC * 1024, MT, NC, 1024, 1024};
                    pg8::StaticOrder S; S.init(MT, NC, gdim, bidx);
                    pg8::EpiC E{ws, out, (const float*)(ws + WS_RS) + (size_t)(2 * l) * MT, IN(21) + i * 64, IN(22) + i * 64, IN(20) + i * 16, i};
                    pg8::gemm_phase<pg8::EpiC, pg8::StaticOrder, true, true>(lds, g, S, E, wv);
#endif
                }
            } else if (kind == 1) {
#ifndef NO_MIXAB
                if (even) mixer_ab(P, lds, i + 8 * rep, z, wv);
#endif
#ifndef NO_MIXC
                if (!even) { fox_cumsum(ws, IN(7), lds, i, wv, gdim, bidx);
                    { XcdBarrier bb; bb.bar = (unsigned*)(ws + WS_BAR); bb.x = xb_xcc_id(); bb.st = (volatile LAS unsigned*)(lds + LDS_SLOT + 16); xcd_barrier(bb, wv); }
                    mixer_c(P, lds, i + 8 * rep, z, wv); }
#endif
            } else if (kind == 3) {
                pg8::Gemm g{(const pg8::bf16_t*)(ws + WS_XB), (const pg8::bf16_t*)(ws + WS_WUP) + (size_t)l * 4194304, MT, DFF, 1024, 1024};
                pg8::StaticOrder S; S.init(MT, DFF, gdim, bidx);
                pg8::EpiUp E{ws, (const float*)(ws + WS_RS) + (size_t)(2 * l + 1) * MT};
#ifndef NO_UP
                pg8::gemm_phase<pg8::EpiUp, pg8::StaticOrder, true, true>(lds, g, S, E, wv);
#endif
            } else {
                const bool down = kind == 4;
                const pg8::bf16_t* A = down ? (const pg8::bf16_t*)R : (const pg8::bf16_t*)(ws + WS_MIX);
                const pg8::bf16_t* Bt = down ? (const pg8::bf16_t*)(ws + WS_WDN) + (size_t)l * 4194304 : (even ? (const pg8::bf16_t*)(ws + WS_WOAB) + (size_t)i * 1048576 : (const pg8::bf16_t*)(ws + WS_WOC) + (size_t)i * 1048576);
                const int Kd = down ? 4096 : 1024;
                pg8::Gemm g{A, Bt, 128 * 256, 1024, Kd, Kd};
                pg8::StaticOrder S; S.init(128 * 256, 1024, gdim, bidx);
                const bool fin = down && l == 3;
                float* ssout = fin ? nullptr : SS + (size_t)(down ? 2 * l + 2 : 2 * l + 1) * MT * 16;
                const bool dry = (PROBE_REP == 4 || PROBE_REP == 2) && nrep == 2 && rep == 0;
                pg8::EpiRes E{ws, ssout, dry ? 2 : (fin ? 1 : 0), out};
#ifndef NO_RES
                pg8::gemm_phase<pg8::EpiRes, pg8::StaticOrder, true, true>(lds, g, S, E, wv);
                if (!dry) { pg8::Gemm g2{A, Bt, MT, 1024, Kd, Kd / 4}; pg8::TailOrder T{gdim, bidx, Kd / 4}; pg8::EpiPart E2{ws, Kd / 4};
                  pg8::gemm_phase<pg8::EpiPart, pg8::TailOrder, true, true>(lds, g2, T, E2, wv); }
                if (!dry) { XcdBarrier bb; bb.bar = (unsigned*)(ws + WS_BAR); bb.x = xb_xcc_id(); bb.st = (volatile LAS unsigned*)(lds + LDS_SLOT + 16); xcd_barrier(bb, wv);
                tail_reduce(ws, out, ssout, (float*)(ws + WS_RS) + (size_t)(down ? 2 * l + 2 : 2 * l + 1) * MT, fin, wv, gdim, bidx); }
#endif
            }
        }
        if (rep + 1 < nrep && P.coop == 1) { XcdBarrier bb; bb.bar = (unsigned*)(ws + WS_BAR); bb.x = xb_xcc_id(); bb.st = (volatile LAS unsigned*)(lds + LDS_SLOT + 16); xcd_barrier(bb, wv); }
        }
        for (int xb_ = 0; xb_ < PROBE_XBAR; ++xb_) { XcdBarrier bb; bb.bar = (unsigned*)(ws + WS_BAR); bb.x = xb_xcc_id(); bb.st = (volatile LAS unsigned*)(lds + LDS_SLOT + 16); xcd_barrier(bb, wv); }
        if (P.coop == 1 && ph + 1 < P.ph_hi) { XcdBarrier bb; bb.bar = (unsigned*)(ws + WS_BAR); bb.x = xb_xcc_id(); bb.st = (volatile LAS unsigned*)(lds + LDS_SLOT + 16); xcd_barrier(bb, wv); }
        else __syncthreads();
    }
}

#ifndef ONE_LAUNCH
#define ONE_LAUNCH 1
#endif
extern "C" void kernel_launch(void* const* d_in, const int* in_sizes, int n_in, void* d_out, int out_size, void* d_ws, size_t ws_size, hipStream_t stream) {
    static int grid = 0;
    if (grid == 0) {
        if (n_in != 26 || (size_t)out_size != O_END || ws_size < WS_END) { fprintf(stderr, "kernel_launch: unexpected shapes: n_in %d out %d ws %zu (need %zu)\n", n_in, out_size, ws_size, (size_t)WS_END); grid = -1; return; }
        int dev = 0, cus = 0, per_cu = 0;
        hipGetDevice(&dev); hipDeviceGetAttribute(&cus, hipDeviceAttributeMultiprocessorCount, dev);
        hipFuncSetAttribute((const void*)hybrid_fwd, hipFuncAttributeMaxDynamicSharedMemorySize, LDS_BYTES);
        if (hipOccupancyMaxActiveBlocksPerMultiprocessor(&per_cu, (const void*)hybrid_fwd, 512, LDS_BYTES) != hipSuccess || per_cu < 1) per_cu = 1;
        (void)hipGetLastError();
        grid = cus * per_cu;
    }
    if (grid < 0) return;
    Params p{};
    for (int i = 0; i < 26; ++i) p.in[i] = (const float*)d_in[i];
    p.out = (float*)d_out; p.ws = (unsigned char*)d_ws;
#if ONE_LAUNCH
    p.ph_lo = 0; p.ph_hi = 21; p.coop = 1;
    if (hipMemsetAsync((char*)d_ws + WS_BAR, 0, 16384, stream) != hipSuccess) { fprintf(stderr, "kernel_launch: memset of the barrier words failed\n"); return; }
    void* args[] = {&p};
    hipError_t e = hipLaunchCooperativeKernel((const void*)hybrid_fwd, dim3(grid), dim3(512), args, LDS_BYTES, stream);
    if (e != hipSuccess) fprintf(stderr, "cooperative launch failed: %s (grid %d)\n", hipGetErrorString(e), grid);
#else
    for (int ph = 0; ph < 21; ++ph) { p.ph_lo = ph; p.ph_hi = ph + 1; p.coop = 0; hipLaunchKernelGGL(hybrid_fwd, dim3(grid), dim3(512), LDS_BYTES, stream, p); }
#endif
}
```

```cpp
#include <hip/hip_runtime.h>
#include <hip/hip_cooperative_groups.h>
#include <cstdio>
#include <cstdint>
namespace cg = cooperative_groups;
namespace pg8 {
#define PG8_LAS __attribute__((address_space(3)))
typedef unsigned short bf16_t;
typedef short bf16x8 __attribute__((ext_vector_type(8)));
typedef float f32x4 __attribute__((ext_vector_type(4)));
typedef unsigned u32x4 __attribute__((ext_vector_type(4)));
constexpr int BM = 256, BK = 64, HALF = 128, HTB = HALF * BK * 2  , STAGE_BYTES = 8 * HTB, NXCD = 8, WGM = 8;

__host__ __device__ __forceinline__ int lds_byte(int r, int c) { const int st = (r >> 4) * 2 + (c >> 5), rr = r & 15, cc = c & 31, ob = rr * 64 + cc * 2; return st * 1024 + (ob ^ (((ob >> 9) & 1) << 5)); }
__host__ __device__ __forceinline__ void stage_rc(int b, int& R, int& C) { const int st = b / 1024, sb = b % 1024, swz = sb ^ (((sb >> 9) & 1) << 5); R = (st >> 1) * 16 + swz / 64; C = (st & 1) * 32 + (swz % 64) / 2; }
__host__ __device__ __forceinline__ int perm32(int rho) { const int n = rho >> 4, i = rho & 15; return 8 * (i >> 2) + 4 * n + (i & 3); }

struct Unit { int pm, pn, k0; };
struct Gemm { const bf16_t* A; const bf16_t* Bt; int M, N, K, klen; };

struct StaticOrder {
    int nM, nN, nwg, G, c;
    __host__ __device__ void init(int M, int N, int G_, int c_) { nM = M / BM; nN = N / BM; nwg = nM * nN; G = G_; c = c_; }
    __host__ __device__ bool next(int i, Unit& u) const {
        const long L = (long)i * G + c; if (L >= nwg) return false;
        int wgid = (int)L; { const int q = nwg / NXCD, r = nwg % NXCD, xcd = wgid % NXCD, off = wgid / NXCD; wgid = (xcd < r ? xcd * (q + 1) : r * (q + 1) + (xcd - r) * q) + off; }
        const int nig = WGM * nN, gid = wgid / nig, fm = gid * WGM, gsz = (nM - fm) < WGM ? (nM - fm) : WGM;
        u.pm = fm + ((wgid % nig) % gsz); u.pn = (wgid % nig) / gsz; u.k0 = 0; return true;
    }
    __device__ __forceinline__ void a_ready(const Unit&) const {}
    __device__ __forceinline__ void done(const Unit&) const {}
};

__device__ __forceinline__ unsigned cvt_pk_bf16(float lo, float hi) { unsigned r; asm volatile("v_cvt_pk_bf16_f32 %0, %1, %2" : "=v"(r) : "v"(lo), "v"(hi)); return r; }
typedef float f32x2 __attribute__((ext_vector_type(2)));
}
constexpr int DM = 1024, NBAT = 16, LP = 2064, MP = NBAT * LP, TS = 32, MS = 16 * TS, MT = MP + MS, NAB = 2560, NC = 3328, DFF = 4096;
constexpr float LOG2E = 1.4426950408889634f;
static_assert(MT % 256 == 0 && MP % 256 == 0, "rows");
constexpr size_t O_YP = 0, O_YS = O_YP + (size_t)16 * 2048 * 1024, O_AKP = O_YS + (size_t)16 * 32 * 1024, O_AVP = O_AKP + 524288, O_BP = O_AVP + 524288,
    O_CKP = O_BP + 1048576, O_CVP = O_CKP + (size_t)2 * MP * 1024, O_CLFP = O_CVP + (size_t)2 * MP * 1024, O_AKS = O_CLFP + (size_t)2 * MP * 16, O_AVS = O_AKS + 524288,
    O_BS = O_AVS + 524288, O_CKS = O_BS + 1048576, O_CVS = O_CKS + 1048576, O_CLFS = O_CVS + 1048576, O_END = O_CLFS + 16384;
constexpr size_t al256(size_t x) { return (x + 255) & ~(size_t)255; }
constexpr size_t WS_CTL = 0, WS_BAR = 4096, WS_SS = 4096 + 16384, WS_ROPE = WS_SS + al256((size_t)8 * MT * 16 * 4), WS_WAB = WS_ROPE + al256((size_t)2096 * 64 * 4),
    WS_WOAB = WS_WAB + (size_t)2 * NAB * 1024 * 2, WS_WC = WS_WOAB + (size_t)2 * 1024 * 1024 * 2, WS_WOC = WS_WC + (size_t)2 * NC * 1024 * 2,
    WS_WUP = WS_WOC + (size_t)2 * 1024 * 1024 * 2, WS_WDN = WS_WUP + (size_t)4 * 4096 * 1024 * 2, WS_X = WS_WDN + (size_t)4 * 4096 * 1024 * 2,
    WS_XB = WS_X + (size_t)MT * 1024 * 4, WS_MIX = WS_XB + (size_t)MT * 1024 * 2, WS_KAS = WS_MIX + (size_t)MT * 1024 * 2,
    WS_VAS = WS_KAS + (size_t)2 * 16 * 160 * 128 * 2, WS_KCS = WS_VAS + (size_t)2 * 16 * 160 * 128 * 2, WS_VCS = WS_KCS + (size_t)2 * 16 * 2080 * 1024 * 2,
    WS_LFS = WS_VCS + (size_t)2 * 16 * 2080 * 1024 * 2, WS_R = WS_LFS + (size_t)2 * 16 * 2080 * 16 * 4, WS_PB = WS_R + (size_t)MT * 4096 * 2, WS_RS = WS_PB + (size_t)4 * 768 * 1024 * 4, WS_END = WS_RS + (size_t)8 * MT * 4;
constexpr size_t R_QA = 0, R_KA = R_QA + (size_t)MT * 512 * 2, R_VA = R_KA + (size_t)MT * 128 * 2, R_QB = R_VA + (size_t)MT * 128 * 2, R_KB = R_QB + (size_t)MT * 256 * 2,
    R_VB = R_KB + (size_t)MT * 256 * 2, R_RB = R_VB + (size_t)MT * 512 * 2, R_GB = R_RB + (size_t)MT * 512 * 2, R_ABEND = R_GB + (size_t)MT * 256 * 4;
constexpr size_t R_QC = 0, R_KC = R_QC + (size_t)MT * 1024 * 2, R_VC = R_KC + (size_t)MT * 1024 * 2, R_LF = R_VC + (size_t)MT * 1024 * 2, R_CEND = R_LF + (size_t)MT * 16 * 4;
static_assert(R_ABEND <= (size_t)MT * 4096 * 2 && R_CEND <= (size_t)MT * 4096 * 2, "region R");
constexpr int LDS_BYTES = 147456, LDS_SLOT = 147200;

namespace pg8 {
constexpr int cMP = MP, cLP = LP, cMT = MT;
#define LAUNDER(p) do { unsigned lz_ = 0u; asm volatile("" : "+s"(lz_)); (p) = (p) + lz_; } while (0)
typedef __bf16 bf16x2_t __attribute__((ext_vector_type(2)));
__device__ __forceinline__ unsigned pk(float lo, float hi) { f32x2 v = {lo, hi}; bf16x2_t b = __builtin_convertvector(v, bf16x2_t); return __builtin_bit_cast(unsigned, b); }
__device__ __forceinline__ void st8bf(bf16_t* p, const f32x4& a, const f32x4& b) { u32x4 w; w.x = pk(a[0], a[1]); w.y = pk(a[2], a[3]); w.z = pk(b[0], b[1]); w.w = pk(b[2], b[3]); *(u32x4*)p = w; }
__device__ __forceinline__ void st8f(float* p, const f32x4& a, const f32x4& b) { *(f32x4*)p = a; *(f32x4*)(p + 4) = b; }
__device__ __forceinline__ float row_rstd(const float* ss, int row) { const f32x4* p = (const f32x4*)(ss + (size_t)row * 16); const f32x4 a = p[0], b = p[1], c = p[2], d = p[3];
    const float s = (((a[0] + a[1]) + (a[2] + a[3])) + ((b[0] + b[1]) + (b[2] + b[3]))) + (((c[0] + c[1]) + (c[2] + c[3])) + ((d[0] + d[1]) + (d[2] + d[3]))); return rsqrtf(s * (1.f / 1024.f) + 1e-6f); }
__device__ __forceinline__ float logsig(float x) { return fminf(x, 0.f) - __logf(1.f + __expf(-fabsf(x))); }

struct EpiUp {
    static constexpr bool PERM = true, AFTER_DRAIN = false;
    unsigned char* ws; const float* ss;
    __device__ __forceinline__ void operator()(const f32x4 (&acc)[2][2][4][2], const Unit& u, int wr, int wc, int fr, int fq) const {
        const int row0 = u.pm * BM + wr * 64 + fr, col0 = u.pn * BM + wc * 32 + 8 * fq;
        unsigned char* w_ = ws; LAUNDER(w_); bf16_t* H = (bf16_t*)(w_ + WS_R);
        float rs8[8];
#pragma unroll
        for (int r8 = 0; r8 < 8; ++r8) rs8[r8] = ss[row0 + (r8 >> 2) * HALF + (r8 & 3) * 16];
#pragma unroll
        for (int ai = 0; ai < 2; ++ai)
#pragma unroll
            for (int m = 0; m < 4; ++m) { const int row = row0 + ai * HALF + m * 16; const float rs = rs8[ai * 4 + m];
                bf16_t* rp = H + (size_t)row * 4096 + col0;
#pragma unroll
                for (int bj = 0; bj < 2; ++bj) { f32x4 a = acc[ai][bj][m][0] * rs, b = acc[ai][bj][m][1] * rs;
#pragma unroll
                    for (int i = 0; i < 4; ++i) { a[i] = fmaxf(a[i], 0.f); a[i] *= a[i]; b[i] = fmaxf(b[i], 0.f); b[i] *= b[i]; }
                    st8bf(rp + bj * HALF, a, b); }
                asm volatile("" ::: "memory"); }
    }
};

struct EpiRes {
    static constexpr bool PERM = true, AFTER_DRAIN = false;
    unsigned char* ws; float* ssout; int fin; float* out;
    __device__ __forceinline__ void operator()(const f32x4 (&acc)[2][2][4][2], const Unit& u, int wr, int wc, int fr, int fq) const {
        if (fin == 2) return;
        const int row0 = u.pm * BM + wr * 64 + fr, col0 = u.pn * BM + wc * 32 + 8 * fq;
        unsigned char* w_ = ws; float* o_ = out; LAUNDER(w_); LAUNDER(o_); bf16_t* XB = (bf16_t*)(w_ + WS_XB); float* yp = o_ + O_YP; float* ys = o_ + O_YS;
#pragma unroll
        for (int ai = 0; ai < 2; ++ai) {
            u32x4 xr[4][2];
#pragma unroll
            for (int m = 0; m < 4; ++m)
#pragma unroll
                for (int bj = 0; bj < 2; ++bj) xr[m][bj] = *(const u32x4*)(XB + (size_t)(row0 + ai * HALF + m * 16) * 1024 + col0 + bj * HALF);
#pragma unroll
            for (int m = 0; m < 4; ++m) { const int row = row0 + ai * HALF + m * 16; float part = 0.f;
                float* op = nullptr; bool ok = true;
                if (fin) { if (row < cMP) { const int b = row / cLP, p = row - b * cLP; ok = p >= 16; op = yp + ((size_t)(b * 2048 + p - 16)) * 1024 + col0; } else op = ys + (size_t)(row - cMP) * 1024 + col0; }
#pragma unroll
                for (int bj = 0; bj < 2; ++bj) { const u32x4 x = xr[m][bj];
                    f32x4 a = (f32x4){__uint_as_float(x.x << 16), __uint_as_float(x.x & 0xffff0000u), __uint_as_float(x.y << 16), __uint_as_float(x.y & 0xffff0000u)} + acc[ai][bj][m][0];
                    f32x4 b = (f32x4){__uint_as_float(x.z << 16), __uint_as_float(x.z & 0xffff0000u), __uint_as_float(x.w << 16), __uint_as_float(x.w & 0xffff0000u)} + acc[ai][bj][m][1];
                    if (fin) { if (ok) st8f(op + bj * HALF, a, b); }
                    else { st8bf(XB + (size_t)row * 1024 + col0 + bj * HALF, a, b);
                        part += (a[0] * a[0] + a[1] * a[1]) + (a[2] * a[2] + a[3] * a[3]) + (b[0] * b[0] + b[1] * b[1]) + (b[2] * b[2] + b[3] * b[3]); } }
                if (!fin && ssout) { part += __shfl_xor(part, 16); part += __shfl_xor(part, 32); if (fq == 0) ssout[(size_t)row * 16 + u.pn * 4 + wc] = part; } }
            asm volatile("" ::: "memory"); }
    }
};

struct EpiAB {
    static constexpr bool PERM = true, AFTER_DRAIN = false;
    unsigned char* ws; float* out; const float *ss, *qn, *kn, *bg; int li;
    __device__ __forceinline__ void operator()(const f32x4 (&acc)[2][2][4][2], const Unit& u, int wr, int wc, int fr, int fq) const {
        const int sg = u.pn * 4 + wc, d0 = 8 * fq, row0 = u.pm * BM + wr * 64 + fr;
        unsigned char* w_ = ws; float* o_ = out; LAUNDER(w_); LAUNDER(o_); unsigned char* R_ = w_ + WS_R; const float* rope = (const float*)(w_ + WS_ROPE);
        bf16_t *QA = (bf16_t*)(R_ + R_QA), *KA = (bf16_t*)(R_ + R_KA), *VA = (bf16_t*)(R_ + R_VA), *QB = (bf16_t*)(R_ + R_QB), *KB = (bf16_t*)(R_ + R_KB), *VB = (bf16_t*)(R_ + R_VB), *RB = (bf16_t*)(R_ + R_RB); float* GB = (float*)(R_ + R_GB);
        bf16_t *KAS = (bf16_t*)(w_ + WS_KAS) + (size_t)li * 16 * 160 * 128, *VAS = (bf16_t*)(w_ + WS_VAS) + (size_t)li * 16 * 160 * 128;
        float *oakp = o_ + O_AKP + (size_t)li * 262144, *oavp = o_ + O_AVP + (size_t)li * 262144, *oaks = o_ + O_AKS + (size_t)li * 262144, *oavs = o_ + O_AVS + (size_t)li * 262144;
        float rs8[8];
#pragma unroll
        for (int r8 = 0; r8 < 8; ++r8) rs8[r8] = ss[row0 + (r8 >> 2) * HALF + (r8 & 3) * 16];
#pragma unroll
        for (int ai = 0; ai < 2; ++ai)
#pragma unroll
            for (int m = 0; m < 4; ++m) { const int row = row0 + ai * HALF + m * 16; const float rs = rs8[ai * 4 + m];
                f32x4 v[2][2];
#pragma unroll
                for (int bj = 0; bj < 2; ++bj)
#pragma unroll
                    for (int n = 0; n < 2; ++n) v[bj][n] = acc[ai][bj][m][n] * rs;
                f32x4 w[2][2];
#pragma unroll
                for (int bj = 0; bj < 2; ++bj)
#pragma unroll
                    for (int n = 0; n < 2; ++n) { const int d = 32 * bj + d0 + 4 * n;
                        if (sg < 8) w[bj][n] = *(const f32x4*)(qn + d); else if (sg < 10) w[bj][n] = *(const f32x4*)(kn + d);
                        else if (sg >= 36) w[bj][n] = *(const f32x4*)(bg + 64 * (sg - 36) + d); else w[bj][n] = (f32x4){0.f, 0.f, 0.f, 0.f}; }
                const bool samp = row >= cMP; int b, p, t, pos;
                if (!samp) { b = row / cLP; p = row - b * cLP; t = 0; pos = p; } else { const int s = row - cMP; b = s >> 5; t = s & 31; p = 0; pos = cLP + t; }
                if (sg < 10) {
                    float q = 0.f;
#pragma unroll
                    for (int bj = 0; bj < 2; ++bj)
#pragma unroll
                        for (int n = 0; n < 2; ++n) q += (v[bj][n][0] * v[bj][n][0] + v[bj][n][1] * v[bj][n][1]) + (v[bj][n][2] * v[bj][n][2] + v[bj][n][3] * v[bj][n][3]);
                    q += __shfl_xor(q, 16); q += __shfl_xor(q, 32);
                    const float r = rsqrtf(q * (1.f / 64.f) + 1e-6f);
                    f32x4 o1[2], o2[2];
#pragma unroll
                    for (int n = 0; n < 2; ++n) { const f32x4 c = *(const f32x4*)(rope + (size_t)pos * 64 + d0 + 4 * n), sn = *(const f32x4*)(rope + (size_t)pos * 64 + 32 + d0 + 4 * n);
                        const f32x4 y1 = v[0][n] * r * w[0][n], y2 = v[1][n] * r * w[1][n];
                        o1[n] = y1 * c - y2 * sn; o2[n] = y2 * c + y1 * sn; }
                    if (sg < 8) { const float sc = 0.125f * 1.4426950408889634f;
                        bf16_t* dp = QA + (size_t)row * 512 + 64 * sg + d0; st8bf(dp, o1[0] * sc, o1[1] * sc); st8bf(dp + 32, o2[0] * sc, o2[1] * sc); }
                    else { const int kvh = sg - 8;
                        bf16_t* dp = KA + (size_t)row * 128 + 64 * kvh + d0; st8bf(dp, o1[0], o1[1]); st8bf(dp + 32, o2[0], o2[1]);
                        if (samp) { bf16_t* d2 = KAS + ((size_t)(b * 160 + 128 + t)) * 128 + 64 * kvh + d0; st8bf(d2, o1[0], o1[1]); st8bf(d2 + 32, o2[0], o2[1]);
                            float* f = oaks + ((size_t)((b * 128 + 96 + t) * 2 + kvh)) * 64 + d0; st8f(f, o1[0], o1[1]); st8f(f + 32, o2[0], o2[1]); }
                        else if (p >= cLP - 128) { float* f = oakp + ((size_t)((b * 128 + p - (cLP - 128)) * 2 + kvh)) * 64 + d0; st8f(f, o1[0], o1[1]); st8f(f + 32, o2[0], o2[1]); } }
                } else if (sg < 12) { const int kvh = sg - 10;
                    bf16_t* dp = VA + (size_t)row * 128 + 64 * kvh + d0; st8bf(dp, v[0][0], v[0][1]); st8bf(dp + 32, v[1][0], v[1][1]);
                    if (samp) { bf16_t* d2 = VAS + ((size_t)(b * 160 + 128 + t)) * 128 + 64 * kvh + d0; st8bf(d2, v[0][0], v[0][1]); st8bf(d2 + 32, v[1][0], v[1][1]);
                        float* f = oavs + ((size_t)((b * 128 + 96 + t) * 2 + kvh)) * 64 + d0; st8f(f, v[0][0], v[0][1]); st8f(f + 32, v[1][0], v[1][1]); }
                    else if (p >= cLP - 128) { float* f = oavp + ((size_t)((b * 128 + p - (cLP - 128)) * 2 + kvh)) * 64 + d0; st8f(f, v[0][0], v[0][1]); st8f(f + 32, v[1][0], v[1][1]); }
                } else if (sg < 16) { bf16_t* dp = QB + (size_t)row * 256 + 64 * (sg - 12) + d0; st8bf(dp, v[0][0] * 0.125f, v[0][1] * 0.125f); st8bf(dp + 32, v[1][0] * 0.125f, v[1][1] * 0.125f);
                } else if (sg < 20) { bf16_t* dp = KB + (size_t)row * 256 + 64 * (sg - 16) + d0; st8bf(dp, v[0][0], v[0][1]); st8bf(dp + 32, v[1][0], v[1][1]);
                } else if (sg < 28) { bf16_t* dp = VB + (size_t)row * 512 + 64 * (sg - 20) + d0; st8bf(dp, v[0][0], v[0][1]); st8bf(dp + 32, v[1][0], v[1][1]);
                } else if (sg < 36) { bf16_t* dp = RB + (size_t)row * 512 + 64 * (sg - 28) + d0; st8bf(dp, v[0][0], v[0][1]); st8bf(dp + 32, v[1][0], v[1][1]);
                } else { float* dp = GB + (size_t)row * 256 + 64 * (sg - 36) + d0;
#pragma unroll
                    for (int bj = 0; bj < 2; ++bj) { f32x4 g0, g1;
#pragma unroll
                        for (int i = 0; i < 4; ++i) { g0[i] = logsig(v[bj][0][i] + w[bj][0][i]) * (1.f / 16.f); g1[i] = logsig(v[bj][1][i] + w[bj][1][i]) * (1.f / 16.f); }
                        st8f(dp + 32 * bj, g0, g1); } }
            }
    }
};

struct EpiC {
    static constexpr bool PERM = true, AFTER_DRAIN = false;
    unsigned char* ws; float* out; const float *ss, *qn, *kn, *bf; int li;
    __device__ __forceinline__ void operator()(const f32x4 (&acc)[2][2][4][2], const Unit& u, int wr, int wc, int fr, int fq) const {
        const int sg = u.pn * 4 + wc, d0 = 8 * fq, row0 = u.pm * BM + wr * 64 + fr;
        if (sg > 48) return;
        unsigned char* w_ = ws; float* o_ = out; LAUNDER(w_); LAUNDER(o_); unsigned char* R_ = w_ + WS_R;
        bf16_t *QC = (bf16_t*)(R_ + R_QC), *KC = (bf16_t*)(R_ + R_KC), *VC = (bf16_t*)(R_ + R_VC); float* LF = (float*)(R_ + R_LF);
        bf16_t *KCS = (bf16_t*)(w_ + WS_KCS) + (size_t)li * 16 * 2080 * 1024, *VCS = (bf16_t*)(w_ + WS_VCS) + (size_t)li * 16 * 2080 * 1024; float* LFS = (float*)(w_ + WS_LFS) + (size_t)li * 16 * 2080 * 16;
        float *ockp = o_ + O_CKP + (size_t)li * MP * 1024, *ocvp = o_ + O_CVP + (size_t)li * MP * 1024, *oclfp = o_ + O_CLFP + (size_t)li * MP * 16, *ocks = o_ + O_CKS + (size_t)li * 524288, *ocvs = o_ + O_CVS + (size_t)li * 524288, *oclfs = o_ + O_CLFS + (size_t)li * 8192;
        float rs8[8];
#pragma unroll
        for (int r8 = 0; r8 < 8; ++r8) rs8[r8] = ss[row0 + (r8 >> 2) * HALF + (r8 & 3) * 16];
#pragma unroll
        for (int ai = 0; ai < 2; ++ai)
#pragma unroll
            for (int m = 0; m < 4; ++m) { const int row = row0 + ai * HALF + m * 16; const float rs = rs8[ai * 4 + m];
                f32x4 v[2][2];
#pragma unroll
                for (int bj = 0; bj < 2; ++bj)
#pragma unroll
                    for (int n = 0; n < 2; ++n) v[bj][n] = acc[ai][bj][m][n] * rs;
                f32x4 w[2][2];
#pragma unroll
                for (int bj = 0; bj < 2; ++bj)
#pragma unroll
                    for (int n = 0; n < 2; ++n) { const int d = 32 * bj + d0 + 4 * n;
                        if (sg < 16) w[bj][n] = *(const f32x4*)(qn + d); else if (sg < 32) w[bj][n] = *(const f32x4*)(kn + d);
                        else if (sg == 48 && bj == 0 && fq < 2) w[bj][n] = *(const f32x4*)(bf + d); else w[bj][n] = (f32x4){0.f, 0.f, 0.f, 0.f}; }
                const bool samp = row >= cMP; const int s = row - cMP, b = s >> 5, t = s & 31;
                const size_t srow = (size_t)(b * 2080 + 2048 + t);
                if (sg < 32) {
                    float q = 0.f;
#pragma unroll
                    for (int bj = 0; bj < 2; ++bj)
#pragma unroll
                        for (int n = 0; n < 2; ++n) q += (v[bj][n][0] * v[bj][n][0] + v[bj][n][1] * v[bj][n][1]) + (v[bj][n][2] * v[bj][n][2] + v[bj][n][3] * v[bj][n][3]);
                    q += __shfl_xor(q, 16); q += __shfl_xor(q, 32);
                    const float r = rsqrtf(q * (1.f / 64.f) + 1e-6f);
#pragma unroll
                    for (int bj = 0; bj < 2; ++bj)
#pragma unroll
                        for (int n = 0; n < 2; ++n) v[bj][n] = v[bj][n] * r * w[bj][n];
                    if (sg < 16) { const float sc = 0.125f * 1.4426950408889634f; bf16_t* dp = QC + (size_t)row * 1024 + 64 * sg + d0; st8bf(dp, v[0][0] * sc, v[0][1] * sc); st8bf(dp + 32, v[1][0] * sc, v[1][1] * sc); }
                    else { const int h = sg - 16;
                        if (!samp) { bf16_t* dp = KC + (size_t)row * 1024 + 64 * h + d0; st8bf(dp, v[0][0], v[0][1]); st8bf(dp + 32, v[1][0], v[1][1]);
                            float* f = ockp + (size_t)row * 1024 + 64 * h + d0; st8f(f, v[0][0], v[0][1]); st8f(f + 32, v[1][0], v[1][1]); }
                        else { bf16_t* dp = KCS + srow * 1024 + 64 * h + d0; st8bf(dp, v[0][0], v[0][1]); st8bf(dp + 32, v[1][0], v[1][1]);
                            float* f = ocks + (size_t)s * 1024 + 64 * h + d0; st8f(f, v[0][0], v[0][1]); st8f(f + 32, v[1][0], v[1][1]); } }
                } else if (sg < 48) { const int h = sg - 32;
                    if (!samp) { bf16_t* dp = VC + (size_t)row * 1024 + 64 * h + d0; st8bf(dp, v[0][0], v[0][1]); st8bf(dp + 32, v[1][0], v[1][1]);
                        float* f = ocvp + (size_t)row * 1024 + 64 * h + d0; st8f(f, v[0][0], v[0][1]); st8f(f + 32, v[1][0], v[1][1]); }
                    else { bf16_t* dp = VCS + srow * 1024 + 64 * h + d0; st8bf(dp, v[0][0], v[0][1]); st8bf(dp + 32, v[1][0], v[1][1]);
                        float* f = ocvs + (size_t)s * 1024 + 64 * h + d0; st8f(f, v[0][0], v[0][1]); st8f(f + 32, v[1][0], v[1][1]); }
                } else if (fq < 2) {
                    f32x4 g0, g1;
#pragma unroll
                    for (int i = 0; i < 4; ++i) { g0[i] = logsig(v[0][0][i] + w[0][0][i]); g1[i] = logsig(v[0][1][i] + w[0][1][i]); }
                    if (!samp) { st8f(LF + (size_t)row * 16 + d0, g0, g1); st8f(oclfp + (size_t)row * 16 + d0, g0, g1); }
                    else { st8f(LFS + srow * 16 + d0, g0, g1); st8f(oclfs + (size_t)s * 16 + d0, g0, g1); }
                }
            }
    }
};

struct TailOrder {
    int G, c, klen;
    __host__ __device__ bool next(int i, Unit& u) const { const int L = i * G + c; if (L >= 48) return false; const int tu = L >> 2, q = L & 3; u.pm = 128 + (tu >> 2); u.pn = tu & 3; u.k0 = q * klen; return true; }
    __device__ __forceinline__ void a_ready(const Unit&) const {}
    __device__ __forceinline__ void done(const Unit&) const {}
};
struct EpiPart {
    static constexpr bool PERM = true, AFTER_DRAIN = false;
    unsigned char* ws; int klen;
    __device__ __forceinline__ void operator()(const f32x4 (&acc)[2][2][4][2], const Unit& u, int wr, int wc, int fr, int fq) const {
        const int row0 = (u.pm - 128) * BM + wr * 64 + fr, col0 = u.pn * BM + wc * 32 + 8 * fq, q = u.k0 / klen;
        unsigned char* w_ = ws; LAUNDER(w_); float* PB = (float*)(w_ + WS_PB) + (size_t)q * 768 * 1024;
#pragma unroll
        for (int ai = 0; ai < 2; ++ai)
#pragma unroll
            for (int m = 0; m < 4; ++m) { float* rp = PB + (size_t)(row0 + ai * HALF + m * 16) * 1024 + col0;
#pragma unroll
                for (int bj = 0; bj < 2; ++bj) st8f(rp + bj * HALF, acc[ai][bj][m][0], acc[ai][bj][m][1]);
                asm volatile("" ::: "memory"); }
    }
};
template <class Epi, class Sched, bool ALIGN_EPI = false, bool SP2 = false>
__device__ __forceinline__ void gemm_phase(PG8_LAS unsigned char* lds, const Gemm g, const Sched& S, const Epi& E, int wv) {
    int tid_ = wv * 64 + (int)__builtin_amdgcn_mbcnt_hi(~0u, __builtin_amdgcn_mbcnt_lo(~0u, 0u)); asm volatile("" : "+v"(tid_));
    const int tid = tid_, wid = __builtin_amdgcn_readfirstlane(tid >> 6), lane = tid & 63, wr = wid >> 2, wc = wid & 3, fr = lane & 15, fq = lane >> 4;
    const int K = g.K, nt = g.klen / BK;
    unsigned voffA[2], voffB[2];
#pragma unroll
    for (int i = 0; i < 2; ++i) { int R, C; stage_rc(tid * 16 + i * 8192, R, C); const int Rb = Epi::PERM ? ((R & ~31) + perm32(R & 31)) : R;
        voffA[i] = (unsigned)(R * K + C) * 2u; voffB[i] = (unsigned)(Rb * K + C) * 2u; }
    const size_t kstep = (size_t)(BK * 2);
    const size_t hstep = (size_t)HALF * K * 2;
    const size_t tstep = 2 * hstep;
    const unsigned ldsw = (unsigned)wid * 1024u;
    const int aoff = lds_byte(wr * 64 + fr, fq * 8), boff = lds_byte(wc * 32 + fr, fq * 8);
#define PG8_SA(b, h) (((b) * 2 + (h)) * HTB)
#define PG8_SB(b, h) ((4 + (b) * 2 + (h)) * HTB)
#define PG8_STAGE(bufoff, gbase, voff) do { _Pragma("unroll") for (int _i = 0; _i < 2; ++_i) \
        __builtin_amdgcn_global_load_lds((const unsigned*)((const char*)(gbase) + (voff)[_i]), (PG8_LAS unsigned*)(lds + (bufoff) + ldsw + _i * 8192), 16, 0, 0); } while (0)
#define PG8_LDA(dst, b, h) do { _Pragma("unroll") for (int m = 0; m < 4; ++m) _Pragma("unroll") for (int k = 0; k < 2; ++k) dst[m][k] = *(const PG8_LAS bf16x8*)(lds + PG8_SA(b, h) + aoff + m * 2048 + k * 1024); } while (0)
#define PG8_LDB(dst, b, h) do { _Pragma("unroll") for (int n = 0; n < 2; ++n) _Pragma("unroll") for (int k = 0; k < 2; ++k) dst[n][k] = *(const PG8_LAS bf16x8*)(lds + PG8_SB(b, h) + boff + n * 2048 + k * 1024); } while (0)
#define PG8_MMA(ai, bj, At, Bt) do { __builtin_amdgcn_s_setprio(1); _Pragma("unroll") for (int m = 0; m < 4; ++m) _Pragma("unroll") for (int n = 0; n < 2; ++n) _Pragma("unroll") for (int k = 0; k < 2; ++k) \
        acc[ai][bj][m][n] = __builtin_amdgcn_mfma_f32_16x16x32_bf16(Bt[n][k], At[m][k], acc[ai][bj][m][n], 0, 0, 0); __builtin_amdgcn_s_setprio(0); } while (0)
#define PG8_WAIT_V(n) asm volatile("s_waitcnt vmcnt(" #n ")" ::: "memory")
#define PG8_WAIT_L(n) asm volatile("s_waitcnt lgkmcnt(" #n ")" ::: "memory")
#define PG8_BAR __builtin_amdgcn_s_barrier()
#define PG8_SCHED __builtin_amdgcn_sched_barrier(0)
    Unit cur, nxt; int ui = 0;
    if (!S.next(0, cur)) return;
    f32x4 acc[2][2][4][2];
#pragma unroll
    for (int a = 0; a < 2; ++a)
#pragma unroll
        for (int b = 0; b < 2; ++b)
#pragma unroll
            for (int m = 0; m < 4; ++m)
#pragma unroll
                for (int n = 0; n < 2; ++n) acc[a][b][m][n] = (f32x4){0.f, 0.f, 0.f, 0.f};
    bf16x8 At[4][2], B0[2][2], B1[2][2];
    const char* cA = (const char*)g.A + (size_t)cur.pm * tstep + (size_t)cur.k0 * 2; const char* cB = (const char*)g.Bt + (size_t)cur.pn * tstep + (size_t)cur.k0 * 2;
    S.a_ready(cur);
    if constexpr (SP2) {
        PG8_STAGE(PG8_SB(0, 0), cB, voffB); PG8_STAGE(PG8_SB(0, 1), cB + hstep, voffB); PG8_STAGE(PG8_SA(0, 0), cA, voffA); PG8_STAGE(PG8_SA(0, 1), cA + hstep, voffA);
        if (wr == 1) PG8_BAR;
        PG8_WAIT_V(2); PG8_BAR;
        PG8_STAGE(PG8_SB(1, 0), cB + kstep, voffB); PG8_STAGE(PG8_SA(1, 0), cA + kstep, voffA); PG8_STAGE(PG8_SB(1, 1), cB + hstep + kstep, voffB);
        PG8_WAIT_V(6); PG8_BAR;
    } else {
        PG8_STAGE(PG8_SB(0, 0), cB, voffB); PG8_STAGE(PG8_SA(0, 0), cA, voffA); PG8_STAGE(PG8_SB(0, 1), cB + hstep, voffB); PG8_STAGE(PG8_SA(0, 1), cA + hstep, voffA);
        if (wr == 1) PG8_BAR;
        PG8_WAIT_V(4); PG8_BAR;
        PG8_STAGE(PG8_SB(1, 0), cB + kstep, voffB); PG8_STAGE(PG8_SA(1, 0), cA + kstep, voffA); PG8_STAGE(PG8_SB(1, 1), cB + hstep + kstep, voffB);
        PG8_WAIT_V(6); PG8_BAR;
    }
    for (;;) {
        const bool has_next = S.next(ui + 1, nxt);
        const char* nA = has_next ? (const char*)g.A + (size_t)nxt.pm * tstep + (size_t)nxt.k0 * 2 : cA; const char* nB = has_next ? (const char*)g.Bt + (size_t)nxt.pn * tstep + (size_t)nxt.k0 * 2 : cB;
        for (int t = 0; t < nt; t += 2) {
            const bool last = (t == nt - 2);
            const char* a1 = cA + (size_t)(t + 1) * kstep;
            const char* a2 = last ? nA : cA + (size_t)(t + 2) * kstep; const char* b2 = last ? nB : cB + (size_t)(t + 2) * kstep;
            const char* a3 = a2 + kstep; const char* b3 = b2 + kstep;
            if (last && has_next) S.a_ready(nxt);
            if constexpr (SP2) {
            PG8_LDB(B0, 0, 0); PG8_LDB(B1, 0, 1); PG8_SCHED; PG8_LDA(At, 0, 0); PG8_STAGE(PG8_SA(1, 1), a1 + hstep, voffA);
            PG8_WAIT_V(8); PG8_WAIT_L(0); PG8_BAR; PG8_MMA(0, 0, At, B0); PG8_MMA(0, 1, At, B1); PG8_BAR; PG8_SCHED;
            PG8_LDA(At, 0, 1); PG8_STAGE(PG8_SB(0, 0), b2, voffB); PG8_STAGE(PG8_SB(0, 1), b2 + hstep, voffB); PG8_STAGE(PG8_SA(0, 0), a2, voffA);
            PG8_WAIT_V(8); PG8_WAIT_L(0); PG8_BAR; PG8_MMA(1, 0, At, B0); PG8_MMA(1, 1, At, B1); PG8_BAR; PG8_SCHED;
            PG8_LDB(B0, 1, 0); PG8_LDB(B1, 1, 1); PG8_SCHED; PG8_LDA(At, 1, 0); PG8_STAGE(PG8_SA(0, 1), a2 + hstep, voffA);
            PG8_WAIT_V(8); PG8_WAIT_L(0); PG8_BAR; PG8_MMA(0, 0, At, B0); PG8_MMA(0, 1, At, B1); PG8_BAR; PG8_SCHED;
            PG8_LDA(At, 1, 1); PG8_STAGE(PG8_SB(1, 0), b3, voffB); PG8_STAGE(PG8_SB(1, 1), b3 + hstep, voffB); PG8_STAGE(PG8_SA(1, 0), a3, voffA);
            PG8_WAIT_V(8); PG8_WAIT_L(0); PG8_BAR; PG8_MMA(1, 0, At, B0); PG8_MMA(1, 1, At, B1); PG8_BAR; PG8_SCHED;
            } else {
            PG8_LDB(B0, 0, 0); PG8_SCHED; PG8_LDA(At, 0, 0); PG8_STAGE(PG8_SA(1, 1), a1 + hstep, voffA);
            PG8_WAIT_L(8); PG8_BAR; PG8_WAIT_L(0); PG8_MMA(0, 0, At, B0); PG8_BAR; PG8_SCHED;
            PG8_LDB(B1, 0, 1); PG8_STAGE(PG8_SB(0, 0), b2, voffB);
            PG8_BAR; PG8_WAIT_L(0); PG8_MMA(0, 1, At, B1); PG8_BAR;
            PG8_LDA(At, 0, 1); PG8_STAGE(PG8_SA(0, 0), a2, voffA);
            PG8_BAR; PG8_WAIT_L(0); PG8_MMA(1, 0, At, B0); PG8_BAR; PG8_SCHED;
            PG8_STAGE(PG8_SB(0, 1), b2 + hstep, voffB);
            PG8_WAIT_V(6); PG8_BAR; PG8_MMA(1, 1, At, B1); PG8_BAR;
            PG8_LDB(B0, 1, 0); PG8_SCHED; PG8_LDA(At, 1, 0); PG8_STAGE(PG8_SA(0, 1), a2 + hstep, voffA);
            PG8_WAIT_L(8); PG8_BAR; PG8_WAIT_L(0); PG8_MMA(0, 0, At, B0); PG8_BAR; PG8_SCHED;
            PG8_LDB(B1, 1, 1); PG8_STAGE(PG8_SB(1, 0), b3, voffB);
            PG8_BAR; PG8_WAIT_L(0); PG8_MMA(0, 1, At, B1); PG8_BAR;
            PG8_LDA(At, 1, 1); PG8_STAGE(PG8_SA(1, 0), a3, voffA);
            PG8_BAR; PG8_WAIT_L(0); PG8_MMA(1, 0, At, B0); PG8_BAR; PG8_SCHED;
            PG8_STAGE(PG8_SB(1, 1), b3 + hstep, voffB);
            PG8_WAIT_V(6); PG8_BAR; PG8_MMA(1, 1, At, B1); PG8_BAR;
            }
        }
        if constexpr (ALIGN_EPI) { if (wr == 0) PG8_BAR; }
        if constexpr (!Epi::AFTER_DRAIN) { E(acc, cur, wr, wc, fr, fq); S.done(cur); }
        if (!has_next) break;
#pragma unroll
        for (int a = 0; a < 2; ++a)
#pragma unroll
            for (int b = 0; b < 2; ++b)
#pragma unroll
                for (int m = 0; m < 4; ++m)
#pragma unroll
                    for (int n = 0; n < 2; ++n) acc[a][b][m][n] = (f32x4){0.f, 0.f, 0.f, 0.f};
        cur = nxt; cA = nA; cB = nB; ++ui;
        if constexpr (ALIGN_EPI) { if (wr == 1) PG8_BAR; }
    }
    PG8_WAIT_V(0);
    if constexpr (!ALIGN_EPI) { if (wr == 0) PG8_BAR; }
    PG8_BAR;
    if constexpr (Epi::AFTER_DRAIN) { E.fused(acc, cur, wr, wc, fr, fq, lds, wid, lane); S.done(cur); }
#undef PG8_SA
#undef PG8_SB
#undef PG8_STAGE
#undef PG8_LDA
#undef PG8_LDB
#undef PG8_MMA
#undef PG8_WAIT_V
#undef PG8_WAIT_L
#undef PG8_BAR
#undef PG8_SCHED
}
}
#define LBAR() asm volatile("s_waitcnt lgkmcnt(0)\n\ts_barrier" ::: "memory")
#ifndef PROBE_C2
#define PROBE_C2 1
#endif
#ifndef PROBE_XBAR
#define PROBE_XBAR 0
#endif
#ifndef PROBE_GLA2
#define PROBE_GLA2 0
#endif
#ifndef PROBE_AB2
#define PROBE_AB2 1
#endif
#define LAS __attribute__((address_space(3)))
typedef unsigned short bf16;
typedef short bf16x8 __attribute__((ext_vector_type(8)));
typedef short bf16x4 __attribute__((ext_vector_type(4)));
typedef float f32x4 __attribute__((ext_vector_type(4)));
typedef unsigned u32x4 __attribute__((ext_vector_type(4)));
typedef unsigned u32x2 __attribute__((ext_vector_type(2)));
using pg8::pk;

struct Params { const float* in[26]; float* out; unsigned char* ws; int ph_lo, ph_hi, coop, pad; };

__device__ __forceinline__ float wave_sum(float v) {
#pragma unroll
    for (int o = 1; o < 64; o <<= 1) v += __shfl_xor(v, o);
    return v;
}
typedef short v4i16_t __attribute__((ext_vector_type(4)));
__device__ __forceinline__ bf16x4 trrd(const LAS unsigned char* p) { return __builtin_bit_cast(bf16x4, __builtin_amdgcn_ds_read_tr16_b64_v4i16((LAS v4i16_t*)p)); }
__device__ __forceinline__ f32x4 mfma16(bf16x8 a, bf16x8 b, f32x4 c) { return __builtin_amdgcn_mfma_f32_16x16x32_bf16(a, b, c, 0, 0, 0); }

template <int KIND>
__device__ __forceinline__ void wt_item(const float* W, const float* Wg, const float* gsc, int K, int N, bf16* WT, LAS float* scr, int item, int lane) {
    const int nblk = N / 32, kb = item / nblk, nb = item % nblk, k0 = 64 * kb, n0 = 32 * nb;
    int L0 = n0;
    if (KIND != 0) { const int pn = n0 >> 8, gq = (n0 & 255) >> 5; L0 = (pn << 8) + 32 * (2 * (gq & 3) + (gq >> 2)); }
    const int L = L0 + (lane & 31);
#pragma unroll 16
    for (int i = 0; i < 32; ++i) { const int kk = 2 * i + (lane >> 5), k = k0 + kk; float v;
        if (KIND == 0) v = W[(size_t)k * N + L];
        else if (KIND == 1) { if (L0 < 2304) v = W[(size_t)k * 2320 + L]; else { float s = 0.f; const float* w1 = W + (size_t)k * 2320 + 2304; const float* w2 = Wg + (L - 2304);
#pragma unroll
                for (int r = 0; r < 16; ++r) s += w1[r] * w2[r * 256]; v = s; } }
        else { const int Lc = L < 3088 ? L : 3087; v = W[(size_t)k * 3088 + Lc]; if (L >= 3088) v = 0.f; }
        if (gsc) v *= gsc[k];
        scr[kk * 33 + (lane & 31)] = v; }
    asm volatile("s_waitcnt lgkmcnt(0)" ::: "memory");
    const int c = lane & 7;
#pragma unroll
    for (int j = 0; j < 4; ++j) { const int n = (lane >> 3) + 8 * j; const LAS float* s = scr + (8 * c) * 33 + n;
        u32x4 o; o.x = pk(s[0 * 33], s[1 * 33]); o.y = pk(s[2 * 33], s[3 * 33]); o.z = pk(s[4 * 33], s[5 * 33]); o.w = pk(s[6 * 33], s[7 * 33]);
        *(u32x4*)(WT + (size_t)(n0 + n) * K + k0 + 8 * c) = o; }
    asm volatile("s_waitcnt lgkmcnt(0)" ::: "memory");
}

constexpr int WI_AB = (1024 / 64) * (NAB / 32), WI_C = (1024 / 64) * (NC / 32), WI_O = (1024 / 64) * (1024 / 32), WI_UP = (1024 / 64) * (4096 / 32), WI_DN = (4096 / 64) * (1024 / 32);
constexpr int WI_ALL = 2 * WI_AB + 2 * WI_C + 4 * WI_O + 4 * WI_UP + 4 * WI_DN;
#define WT_DISPATCH(it_) do { int r = (it_); constexpr int I_AB = WI_AB, I_C = WI_C, I_O = WI_O, I_UP = WI_UP, I_DN = WI_DN; \
            if (r < 2 * I_AB) { const int i = r / I_AB; r %= I_AB; wt_item<1>(IN(11) + (size_t)i * 1024 * 2320, IN(15) + (size_t)i * 16 * 256, IN(9) + (size_t)(2 * i) * 1024, 1024, NAB, (bf16*)(ws + WS_WAB) + (size_t)i * NAB * 1024, scr, r, lane); break; } r -= 2 * I_AB; \
            if (r < 2 * I_C) { const int i = r / I_C; r %= I_C; wt_item<2>(IN(19) + (size_t)i * 1024 * 3088, nullptr, IN(9) + (size_t)(2 * i + 1) * 1024, 1024, NC, (bf16*)(ws + WS_WC) + (size_t)i * NC * 1024, scr, r, lane); break; } r -= 2 * I_C; \
            if (r < 4 * I_O) { const int i = r / I_O; r %= I_O; const float* src = (i < 2) ? IN(18) + (size_t)i * 1048576 : IN(23) + (size_t)(i - 2) * 1048576; \
                bf16* dst = (i < 2) ? (bf16*)(ws + WS_WOAB) + (size_t)i * 1048576 : (bf16*)(ws + WS_WOC) + (size_t)(i - 2) * 1048576; wt_item<0>(src, nullptr, nullptr, 1024, 1024, dst, scr, r, lane); break; } r -= 4 * I_O; \
            if (r < 4 * I_UP) { const int l = r / I_UP; r %= I_UP; wt_item<0>(IN(24) + (size_t)l * 4194304, nullptr, IN(10) + (size_t)l * 1024, 1024, 4096, (bf16*)(ws + WS_WUP) + (size_t)l * 4194304, scr, r, lane); break; } r -= 4 * I_UP; \
            { const int l = r / I_DN; r %= I_DN; wt_item<0>(IN(25) + (size_t)l * 4194304, nullptr, nullptr, 4096, 1024, (bf16*)(ws + WS_WDN) + (size_t)l * 4194304, scr, r, lane); } \
    } while (0)
__device__ __forceinline__ void prologue(const Params& P, LAS unsigned char* lds, int z, int wv, int gdim, int bidx) {
#define IN(k) (P.in[(k) + z])
    float* out = P.out + z;
    int tid_ = wv * 64 + (int)__builtin_amdgcn_mbcnt_hi(~0u, __builtin_amdgcn_mbcnt_lo(~0u, 0u)); asm volatile("" : "+v"(tid_)); const int tid = tid_, lane = tid & 63, wave = __builtin_amdgcn_readfirstlane(tid >> 6);
    const int gw = bidx * 8 + wave, NGW = gdim * 8;
    const size_t gt = (size_t)bidx * 512 + tid, NGT = (size_t)gdim * 512;
    unsigned char* ws = P.ws + z;
    LAS float* scr = (LAS float*)(lds + wave * 16384);
    for (int it = gw; it < WI_AB; it += NGW) WT_DISPATCH(it);
    {
        float* X = (float*)(ws + WS_X); bf16* XB = (bf16*)(ws + WS_XB); float* SS = (float*)(ws + WS_SS);
        for (int row0 = gw; row0 < MT; row0 += 4 * NGW) { f32x4 v[4][4];
#pragma unroll
            for (int u = 0; u < 4; ++u) { const int row = row0 + u * NGW; if (row < MT) { const float* src;
                if (row < MP) { const int b = row / LP, p = row - b * LP; src = (p < 16) ? IN(8) + (size_t)p * 1024 : IN(0) + ((size_t)b * 2048 + (p - 16)) * 1024; } else src = IN(1) + (size_t)(row - MP) * 1024;
#pragma unroll
                for (int j = 0; j < 4; ++j) v[u][j] = *(const f32x4*)(src + 256 * j + 4 * lane); } }
#pragma unroll
            for (int u = 0; u < 4; ++u) { const int row = row0 + u * NGW; if (row < MT) { float s = 0.f;
#pragma unroll
                for (int j = 0; j < 4; ++j) { const f32x4 x = v[u][j]; s += (x[0] * x[0] + x[1] * x[1]) + (x[2] * x[2] + x[3] * x[3]);
                    u32x2 w; w.x = pk(x[0], x[1]); w.y = pk(x[2], x[3]); *(u32x2*)(XB + (size_t)row * 1024 + 256 * j + 4 * lane) = w; }
                s = wave_sum(s); if (lane == 0) ((float*)(ws + WS_RS))[row] = rsqrtf(s * (1.f / 1024.f) + 1e-6f); } } }
        if (gt < 16) ((unsigned*)(ws + WS_CTL))[gt] = 0u;
    }
    {
        bf16* KAS = (bf16*)(ws + WS_KAS); bf16* VAS = (bf16*)(ws + WS_VAS);
        for (size_t i = gt; i < (size_t)2 * 16 * 128 * 128; i += NGT) { const size_t ib = i / (128 * 128), rem = i % (128 * 128); const int pos = (int)(rem / 128), c = (int)(rem % 128);
            const float kx = IN(2)[i], vx = IN(3)[i];
            KAS[(ib * 160 + pos) * 128 + c] = (bf16)(pk(kx, 0.f) & 0xffffu); VAS[(ib * 160 + pos) * 128 + c] = (bf16)(pk(vx, 0.f) & 0xffffu);
            if (pos >= 32) { out[O_AKS + (ib * 128 + pos - 32) * 128 + c] = kx; out[O_AVS + (ib * 128 + pos - 32) * 128 + c] = vx; } }
    }
    {
        float* RT = (float*)(ws + WS_ROPE);
        for (size_t i = gt; i < (size_t)2096 * 32; i += NGT) { const int pos = (int)(i >> 5), j = (int)(i & 31);
            const float inv = powf(10000.f, -(float)j / 32.f); const float ang = (float)pos * inv; float sn, cs; sincosf(ang, &sn, &cs);
            RT[(size_t)pos * 64 + j] = cs; RT[(size_t)pos * 64 + 32 + j] = sn; }
    }
}

struct AttnBlk { const bf16* k; const bf16* v; const float* lf; int kld, vld, lfld, klo, khi, t0, t1, q0pos; float qkb; };
struct AttnWave { const bf16* q; bf16* o; int qld, old, ilo, ihi, qpos, active; float sink2; };
constexpr int AT_KS = 0, AT_VT = 8192, AT_CS = 16384, AT_BUF = 16640;
__device__ __forceinline__ int swz(int row, int chunk) { return row * 128 + ((chunk ^ (row & 7)) << 4); }

template <bool FOX>
__device__ __forceinline__ void attn_unit(LAS unsigned char* lds, const AttnBlk B, const AttnWave W, int wv) {
    int tid_ = wv * 64 + (int)__builtin_amdgcn_mbcnt_hi(~0u, __builtin_amdgcn_mbcnt_lo(~0u, 0u)); asm volatile("" : "+v"(tid_)); const int tid = tid_, lane = tid & 63, wid = __builtin_amdgcn_readfirstlane(tid >> 6), l15 = lane & 15, quad = lane >> 4;
    bf16x8 qf[2][2];
#pragma unroll
    for (int nq = 0; nq < 2; ++nq) { int i = 16 * nq + l15; i = i < W.ilo ? W.ilo : i; i = i >= W.ihi ? W.ihi - 1 : i;
        if (W.active) { const bf16* qp = W.q + (ptrdiff_t)i * W.qld + quad * 8; qf[nq][0] = *(const bf16x8*)qp; qf[nq][1] = *(const bf16x8*)(qp + 32); }
        else { qf[nq][0] = (bf16x8){0, 0, 0, 0, 0, 0, 0, 0}; qf[nq][1] = qf[nq][0]; } }
    float mrun[2] = {-1e30f, -1e30f}, lrun[2] = {0.f, 0.f};
    f32x4 ot[4][2];
#pragma unroll
    for (int a = 0; a < 4; ++a)
#pragma unroll
        for (int b = 0; b < 2; ++b) ot[a][b] = (f32x4){0.f, 0.f, 0.f, 0.f};
    float ctq[2] = {0.f, 0.f};
    if (FOX && W.active) {
#pragma unroll
        for (int nq = 0; nq < 2; ++nq) { int qp = W.qpos + 16 * nq + l15; qp = qp >= B.khi ? B.khi - 1 : qp; ctq[nq] = B.lf[(ptrdiff_t)qp * B.lfld]; } }
    u32x4 kreg, vreg, kreg2, vreg2; float lfreg = 0.f, lfreg2 = 0.f;
#define AT_ISSUE(t, kreg, vreg, lfreg) do { const int kk_ = (t) * 64 + (tid >> 3); int kc_ = kk_ < B.klo ? B.klo : kk_; kc_ = kc_ >= B.khi ? B.khi - 1 : kc_; \
        kreg = *(const u32x4*)(B.k + (ptrdiff_t)kc_ * B.kld + (tid & 7) * 8); vreg = *(const u32x4*)(B.v + (ptrdiff_t)kc_ * B.vld + (tid & 7) * 8); \
        if (FOX && wid == 0) { const int kl_ = (t) * 64 + lane; int kd_ = kl_ < B.klo ? B.klo : kl_; kd_ = kd_ >= B.khi ? B.khi - 1 : kd_; lfreg = (kl_ >= B.klo && kl_ < B.khi) ? B.lf[(ptrdiff_t)kd_ * B.lfld] : 0.f; } } while (0)
#define AT_COMMIT(buf) do { LAS unsigned char* base_ = lds + (buf) * AT_BUF; \
        *(LAS u32x4*)(base_ + AT_KS + swz(tid >> 3, tid & 7)) = kreg; \
        *(LAS u32x4*)(base_ + AT_VT + swz(tid >> 3, tid & 7)) = vreg; \
        if (FOX && wid == 0) { float x_ = lfreg; \
            ((LAS float*)(base_ + AT_CS))[lane] = -x_; } } while (0)
    int tbeg = B.t0;
    if (FOX) {
        int ke = 64 * lane + 63; ke = ke >= B.khi ? B.khi - 1 : ke; const float cend = B.lf[(ptrdiff_t)ke * B.lfld], cq0 = B.lf[(ptrdiff_t)B.q0pos * B.lfld];
        const bool keep = (lane >= B.t1 - 1) || (B.qkb + cq0 - cend >= -160.f);
        const unsigned long long bm = __ballot(keep); tbeg = (int)__ffsll((long long)bm) - 1; tbeg = __builtin_amdgcn_readfirstlane(tbeg); if (tbeg < B.t0) tbeg = B.t0;
    }
    AT_ISSUE(tbeg, kreg, vreg, lfreg); AT_COMMIT(0);
    if (tbeg + 1 < B.t1) AT_ISSUE(tbeg + 1, kreg, vreg, lfreg);
    for (int t = tbeg; t < B.t1; ++t) {
        const int buf = (t - tbeg) & 1;
        LBAR();
        if (t + 2 < B.t1) AT_ISSUE(t + 2, kreg2, vreg2, lfreg2);
        if (W.active) {
            LAS unsigned char* base = lds + buf * AT_BUF;
            f32x4 st[4][2];
#pragma unroll
            for (int kb = 0; kb < 4; ++kb) { const bf16x8 k0 = *(const LAS bf16x8*)(base + AT_KS + swz(16 * kb + l15, quad)), k1 = *(const LAS bf16x8*)(base + AT_KS + swz(16 * kb + l15, 4 + quad));
                f32x4 ci = (f32x4){0.f, 0.f, 0.f, 0.f}; if (FOX) ci = *(const LAS f32x4*)(base + AT_CS + (16 * kb + 4 * quad) * 4);
#pragma unroll
                for (int nq = 0; nq < 2; ++nq) { st[kb][nq] = mfma16(k0, qf[nq][0], ci); st[kb][nq] = mfma16(k1, qf[nq][1], st[kb][nq]); } }
            const bool needmask = FOX ? (64 * t + 63 > W.qpos) : (64 * t < B.klo || 64 * t + 64 > B.khi);
            if (needmask) {
#pragma unroll
                for (int kb = 0; kb < 4; ++kb)
#pragma unroll
                    for (int j = 0; j < 4; ++j) { const int kk = 64 * t + 16 * kb + 4 * quad + j; const bool kout = (kk < B.klo) || (kk >= B.khi);
#pragma unroll
                        for (int nq = 0; nq < 2; ++nq) { const int qp = W.qpos + 16 * nq + l15; if (kout || (FOX && kk > qp)) st[kb][nq][j] = -1e30f; } } }
            bf16x8 pf[2][2];
#pragma unroll
            for (int nq = 0; nq < 2; ++nq) {
                if (FOX) {
                    float ps = 0.f;
#pragma unroll
                    for (int kb = 0; kb < 4; ++kb)
#pragma unroll
                        for (int j = 0; j < 4; ++j) { const float p = __builtin_amdgcn_exp2f(st[kb][nq][j] + ctq[nq]); st[kb][nq][j] = p; ps += p; }
                    lrun[nq] += ps;
                } else {
                float mx = st[0][nq][0];
#pragma unroll
                for (int kb = 0; kb < 4; ++kb)
#pragma unroll
                    for (int j = 0; j < 4; ++j) mx = fmaxf(mx, st[kb][nq][j]);
                mx = fmaxf(mx, __shfl_xor(mx, 16)); mx = fmaxf(mx, __shfl_xor(mx, 32));
                const float mn = fmaxf(mrun[nq], mx), al = __builtin_amdgcn_exp2f(mrun[nq] - mn); mrun[nq] = mn; float ps = 0.f;
#pragma unroll
                for (int kb = 0; kb < 4; ++kb)
#pragma unroll
                    for (int j = 0; j < 4; ++j) { const float p = __builtin_amdgcn_exp2f(st[kb][nq][j] - mn); st[kb][nq][j] = p; ps += p; }
                lrun[nq] = lrun[nq] * al + ps;
#pragma unroll
                for (int db = 0; db < 4; ++db) ot[db][nq] *= al;
                }
#pragma unroll
                for (int kh = 0; kh < 2; ++kh) { u32x4 w; w.x = pk(st[2 * kh][nq][0], st[2 * kh][nq][1]); w.y = pk(st[2 * kh][nq][2], st[2 * kh][nq][3]); w.z = pk(st[2 * kh + 1][nq][0], st[2 * kh + 1][nq][1]); w.w = pk(st[2 * kh + 1][nq][2], st[2 * kh + 1][nq][3]);
                    pf[kh][nq] = __builtin_bit_cast(bf16x8, w); } }
#pragma unroll
            for (int db = 0; db < 4; ++db)
#pragma unroll
                for (int kh = 0; kh < 2; ++kh) { const LAS unsigned char* vp = base + AT_VT + swz(32 * kh + 4 * quad + (l15 >> 2), 2 * db + ((lane & 3) >> 1)) + 8 * (lane & 1);
                    const bf16x4 lo = trrd(vp), hi = trrd(vp + 16 * 128);
                    const bf16x8 vf = (bf16x8){lo[0], lo[1], lo[2], lo[3], hi[0], hi[1], hi[2], hi[3]};
#pragma unroll
                    for (int nq = 0; nq < 2; ++nq) ot[db][nq] = mfma16(vf, pf[kh][nq], ot[db][nq]); }
        }
        if (t + 1 < B.t1) AT_COMMIT(buf ^ 1);
        kreg = kreg2; vreg = vreg2; lfreg = lfreg2;
    }
#undef AT_ISSUE
#undef AT_COMMIT
    if (W.active) {
#pragma unroll
        for (int nq = 0; nq < 2; ++nq) { float lt = lrun[nq]; lt += __shfl_xor(lt, 16); lt += __shfl_xor(lt, 32); float sc;
            if (FOX) sc = 1.f / lt; else { const float mf = fmaxf(mrun[nq], W.sink2), a = __builtin_amdgcn_exp2f(mrun[nq] - mf); lt = lt * a + __builtin_amdgcn_exp2f(W.sink2 - mf); sc = a / lt; }
            const int i = 16 * nq + l15;
            if (i >= W.ilo && i < W.ihi) {
#pragma unroll
                for (int db = 0; db < 4; ++db) { const f32x4 o = ot[db][nq] * sc; u32x2 w; w.x = pk(o[0], o[1]); w.y = pk(o[2], o[3]); *(u32x2*)(W.o + (ptrdiff_t)i * W.old + 16 * db + 4 * quad) = w; } } }
    }
    __syncthreads();
}


struct FoxS { const float *kc, *vc, *lf; const bf16 *kn, *vn; const bf16* q; bf16* o; float qkb; };
__device__ __forceinline__ void fox_sample_unit(LAS unsigned char* lds, const FoxS J, int wv) {
    int tid_ = wv * 64 + (int)__builtin_amdgcn_mbcnt_hi(~0u, __builtin_amdgcn_mbcnt_lo(~0u, 0u)); asm volatile("" : "+v"(tid_)); const int tid = tid_, lane = tid & 63, wid = wv, l15 = lane & 15, quad = lane >> 4;
    const int kb = wid & 3, nq = wid >> 2;
    bf16x8 qf[2];
    { const bf16* qp = J.q + (ptrdiff_t)(16 * nq + l15) * 1024 + quad * 8; qf[0] = *(const bf16x8*)qp; qf[1] = *(const bf16x8*)(qp + 32); }
    float lrun = 0.f; f32x4 ot[4]; const float ctq = J.lf[(size_t)(2048 + 16 * nq + l15) * 16];
#pragma unroll
    for (int a = 0; a < 4; ++a) ot[a] = (f32x4){0.f, 0.f, 0.f, 0.f};
    f32x4 ka_, kb_, va_, vb_; float lfreg = 0.f;
    const int skey = tid >> 3, sch = tid & 7;
#define FS_ISSUE(t) do { if ((t) < 32) { const float* kp_ = J.kc + (size_t)((t) * 64 + skey) * 1024 + sch * 8; const float* vp_ = J.vc + (size_t)((t) * 64 + skey) * 1024 + sch * 8; \
            ka_ = __builtin_nontemporal_load((const f32x4*)kp_); kb_ = __builtin_nontemporal_load((const f32x4*)(kp_ + 4)); va_ = __builtin_nontemporal_load((const f32x4*)vp_); vb_ = __builtin_nontemporal_load((const f32x4*)(vp_ + 4)); \
            if (wid == 0) lfreg = J.lf[(size_t)((t) * 64 + lane) * 16]; } \
        else { const int kr_ = skey < 32 ? skey : 31; ka_ = *(const f32x4*)(J.kn + (size_t)kr_ * 1024 + sch * 8); va_ = *(const f32x4*)(J.vn + (size_t)kr_ * 1024 + sch * 8); \
            if (wid == 0) lfreg = lane < 32 ? J.lf[(size_t)(2048 + lane) * 16] : 0.f; } } while (0)
#define FS_COMMIT(buf, tt) do { LAS unsigned char* base_ = lds + (buf) * AT_BUF; u32x4 kreg, vreg; \
        if ((tt) < 32) { kreg = (u32x4){pk(ka_[0], ka_[1]), pk(ka_[2], ka_[3]), pk(kb_[0], kb_[1]), pk(kb_[2], kb_[3])}; vreg = (u32x4){pk(va_[0], va_[1]), pk(va_[2], va_[3]), pk(vb_[0], vb_[1]), pk(vb_[2], vb_[3])}; } \
        else { kreg = __builtin_bit_cast(u32x4, ka_); vreg = __builtin_bit_cast(u32x4, va_); } \
        *(LAS u32x4*)(base_ + AT_KS + swz(skey, sch)) = kreg; *(LAS u32x4*)(base_ + AT_VT + swz(skey, sch)) = vreg; \
        if (wid == 0) ((LAS float*)(base_ + AT_CS))[lane] = -lfreg; } while (0)
    int tbeg;
    { int ke = 64 * lane + 63; ke = ke > 2079 ? 2079 : ke; const float cend = J.lf[(size_t)ke * 16], cq0 = J.lf[(size_t)2048 * 16];
      const bool keep = (lane >= 32) || (J.qkb + cq0 - cend >= -160.f);
      const unsigned long long bm = __ballot(keep); tbeg = __builtin_amdgcn_readfirstlane((int)__ffsll((long long)bm) - 1); }
    FS_ISSUE(tbeg); FS_COMMIT(0, tbeg);
    for (int t = tbeg; t < 33; ++t) {
        const int buf = (t - tbeg) & 1;
        LBAR();
        if (t + 1 < 33) FS_ISSUE(t + 1);
        {
            LAS unsigned char* base = lds + buf * AT_BUF;
            const bf16x8 k0 = *(const LAS bf16x8*)(base + AT_KS + swz(16 * kb + l15, quad)), k1 = *(const LAS bf16x8*)(base + AT_KS + swz(16 * kb + l15, 4 + quad));
            const f32x4 c = *(const LAS f32x4*)(base + AT_CS + (16 * kb + 4 * quad) * 4);
            f32x4 st = mfma16(k0, qf[0], c); st = mfma16(k1, qf[1], st);
            if (t == 32) {
#pragma unroll
                for (int j = 0; j < 4; ++j) { const int kk = 2048 + 16 * kb + 4 * quad + j; if (kk >= 2080 || kk > 2048 + 16 * nq + l15) st[j] = -1e30f; } }
            float p[4]; float ps = 0.f;
#pragma unroll
            for (int j = 0; j < 4; ++j) { p[j] = __builtin_amdgcn_exp2f(st[j] + ctq); ps += p[j]; }
            lrun += ps;
            u32x4 w; w.x = pk(p[0], p[1]); w.y = pk(p[2], p[3]); w.z = 0u; w.w = 0u; const bf16x8 pf = __builtin_bit_cast(bf16x8, w);
#pragma unroll
            for (int db = 0; db < 4; ++db) { const bf16x4 lo = trrd(base + AT_VT + swz(16 * kb + 4 * quad + (l15 >> 2), 2 * db + ((lane & 3) >> 1)) + 8 * (lane & 1));
                ot[db] = mfma16((bf16x8){lo[0], lo[1], lo[2], lo[3], lo[0], lo[1], lo[2], lo[3]}, pf, ot[db]); }
        }
        if (t + 1 < 33) FS_COMMIT(buf ^ 1, t + 1);
    }
#undef FS_ISSUE
#undef FS_COMMIT
    __syncthreads();
    { float lt = lrun; lt += __shfl_xor(lt, 16); lt += __shfl_xor(lt, 32);
      LAS float* ML = (LAS float*)(lds + 32768); if (quad == 0) ML[wid * 32 + 16 + l15] = lt;
      LAS float* OP = (LAS float*)lds + wid * 1024;
#pragma unroll
      for (int db = 0; db < 4; ++db)
#pragma unroll
          for (int j = 0; j < 4; ++j) OP[(16 * db + 4 * quad + j) * 16 + l15] = ot[db][j]; }
    __syncthreads();
    { const int n2 = tid >> 8, q = (tid >> 4) & 15, dg = tid & 15; const LAS float* ML = (const LAS float*)(lds + 32768);
      float L = 0.f, o[4] = {0.f, 0.f, 0.f, 0.f};
#pragma unroll
      for (int k = 0; k < 4; ++k) { const int w = n2 * 4 + k; L += ML[w * 32 + 16 + q]; const LAS float* OPw = (const LAS float*)lds + w * 1024;
#pragma unroll
          for (int e = 0; e < 4; ++e) o[e] += OPw[(4 * dg + e) * 16 + q]; }
      const float inv = 1.f / L; u32x2 w2; w2.x = pk(o[0] * inv, o[1] * inv); w2.y = pk(o[2] * inv, o[3] * inv);
      *(u32x2*)(J.o + (ptrdiff_t)(16 * n2 + q) * 1024 + 4 * dg) = w2; }
    __syncthreads();
}

struct GlaJob { const bf16 *q, *k, *v, *rb; const float* g; bf16* mix; const float* s0; float* sout; const float* onorm; int nchunks, tlo0, thi; };
constexpr int GL_QE = 0, GL_KE = 9216, GL_K2T = 18432, GL_VT = 27648, GL_ST = 46080, GL_SEG = 82944, GL_BLD = 84992, GL_OB = 85248;

__device__ __forceinline__ void gla_unit(LAS unsigned char* lds, const GlaJob J, int wv) {
    int tid_ = wv * 64 + (int)__builtin_amdgcn_mbcnt_hi(~0u, __builtin_amdgcn_mbcnt_lo(~0u, 0u)); asm volatile("" : "+v"(tid_)); const int tid = tid_, lane = tid & 63, wid = __builtin_amdgcn_readfirstlane(tid >> 6), l15 = lane & 15, quad = lane >> 4;
    float gr[8]; unsigned short qr[8], kr[8]; u32x4 vr[2], rn[2], rc[2];
    const int rlo_ = J.tlo0, rhi_ = 64 * (J.nchunks - 1) + J.thi - 1;
#define GL_LOAD(c) do { const int cc_ = (c) < J.nchunks ? (c) : J.nchunks - 1; \
        _Pragma("unroll") for (int tt = 0; tt < 8; ++tt) { int r_ = 64 * cc_ + 8 * wid + tt; r_ = r_ < rlo_ ? rlo_ : r_; r_ = r_ > rhi_ ? rhi_ : r_; \
            gr[tt] = J.g[(ptrdiff_t)r_ * 256 + lane]; qr[tt] = J.q[(ptrdiff_t)r_ * 256 + lane]; kr[tt] = J.k[(ptrdiff_t)r_ * 256 + lane]; } \
        { int r_ = 64 * cc_ + lane; r_ = r_ < rlo_ ? rlo_ : r_; r_ = r_ > rhi_ ? rhi_ : r_; vr[0] = *(const u32x4*)(J.v + (ptrdiff_t)r_ * 512 + wid * 16); vr[1] = *(const u32x4*)(J.v + (ptrdiff_t)r_ * 512 + wid * 16 + 8); } \
        { int r_ = 64 * cc_ + (tid >> 3); r_ = r_ < rlo_ ? rlo_ : r_; r_ = r_ > rhi_ ? rhi_ : r_; rn[0] = *(const u32x4*)(J.rb + (ptrdiff_t)r_ * 512 + 16 * (tid & 7)); rn[1] = *(const u32x4*)(J.rb + (ptrdiff_t)r_ * 512 + 16 * (tid & 7) + 8); } } while (0)
#define GL_FIX(c) do { const int lo_ = ((c) == 0) ? J.tlo0 : 0; \
        _Pragma("unroll") for (int tt = 0; tt < 8; ++tt) { const int t_ = 8 * wid + tt; const bool ok_ = t_ >= lo_ && t_ < J.thi; gr[tt] = ok_ ? gr[tt] : 0.f; qr[tt] = ok_ ? qr[tt] : (unsigned short)0; kr[tt] = ok_ ? kr[tt] : (unsigned short)0; } \
        { const bool ok_ = lane >= lo_ && lane < J.thi; if (!ok_) { vr[0] = (u32x4){0u, 0u, 0u, 0u}; vr[1] = vr[0]; } } } while (0)
    GL_LOAD(0);
    f32x4 sacc[4];
#pragma unroll
    for (int mb = 0; mb < 4; ++mb) {
#pragma unroll
        for (int j = 0; j < 4; ++j) sacc[mb][j] = J.s0 ? J.s0[(size_t)(16 * mb + 4 * quad + j) * 128 + 16 * wid + l15] : 0.f;
        u32x2 w; w.x = pk(sacc[mb][0], sacc[mb][1]); w.y = pk(sacc[mb][2], sacc[mb][3]);
        *(LAS u32x2*)(lds + GL_ST + (16 * wid + l15) * 144 + (16 * mb + 4 * quad) * 2) = w; }
    for (int c = 0; c < J.nchunks; ++c) {
        const int cur = c & 1; GL_FIX(c); rc[0] = rn[0]; rc[1] = rn[1];
        float bl[8], qv[8], kv[8]; float run = 0.f;
#pragma unroll
        for (int tt = 0; tt < 8; ++tt) { run += gr[tt]; bl[tt] = run; qv[tt] = __uint_as_float((unsigned)qr[tt] << 16); kv[tt] = __uint_as_float((unsigned)kr[tt] << 16); }
        ((LAS float*)(lds + GL_SEG))[wid * 64 + lane] = run;
        { LAS bf16* vt = (LAS bf16*)(lds + GL_VT) + (wid * 16) * 72 + lane;
#pragma unroll
          for (int h = 0; h < 2; ++h) { const u32x4 x = vr[h]; LAS bf16* p = vt + h * 8 * 72;
              p[0 * 72] = (bf16)(x.x & 0xffffu); p[1 * 72] = (bf16)(x.x >> 16); p[2 * 72] = (bf16)(x.y & 0xffffu); p[3 * 72] = (bf16)(x.y >> 16);
              p[4 * 72] = (bf16)(x.z & 0xffffu); p[5 * 72] = (bf16)(x.z >> 16); p[6 * 72] = (bf16)(x.w & 0xffffu); p[7 * 72] = (bf16)(x.w >> 16); } }
        LBAR();
        float pre = 0.f, tot = 0.f;
#pragma unroll
        for (int s = 0; s < 8; ++s) { const float x = ((const LAS float*)(lds + GL_SEG))[s * 64 + lane]; tot += x; if (s < wid) pre += x; }
        float k2[8];
#pragma unroll
        for (int tt = 0; tt < 8; ++tt) { const float b = pre + bl[tt]; const float eb = __expf(b), enb = __expf(-b);
            ((LAS bf16*)(lds + GL_QE))[(8 * wid + tt) * 72 + lane] = (bf16)(pk(qv[tt] * eb, 0.f) & 0xffffu);
            ((LAS bf16*)(lds + GL_KE))[(8 * wid + tt) * 72 + lane] = (bf16)(pk(kv[tt] * enb, 0.f) & 0xffffu);
            k2[tt] = kv[tt] * __expf(tot - b); }
        { u32x4 w; w.x = pk(k2[0], k2[1]); w.y = pk(k2[2], k2[3]); w.z = pk(k2[4], k2[5]); w.w = pk(k2[6], k2[7]); *(LAS u32x4*)(lds + GL_K2T + lane * 144 + wid * 16) = w; }
        if (wid == 0) ((LAS float*)(lds + GL_BLD))[lane] = __expf(tot);
        GL_LOAD(c + 1);
        LBAR();
        {
            const int tb = wid & 3, half = wid >> 2;
            bf16x8 qb[2];
            qb[0] = *(const LAS bf16x8*)(lds + GL_QE + (16 * tb + l15) * 144 + quad * 16); qb[1] = *(const LAS bf16x8*)(lds + GL_QE + (16 * tb + l15) * 144 + 64 + quad * 16);
            f32x4 at[4];
#pragma unroll
            for (int sb = 0; sb < 4; ++sb) { at[sb] = (f32x4){0.f, 0.f, 0.f, 0.f};
                if (sb <= tb) { const bf16x8 a0 = *(const LAS bf16x8*)(lds + GL_KE + (16 * sb + l15) * 144 + quad * 16), a1 = *(const LAS bf16x8*)(lds + GL_KE + (16 * sb + l15) * 144 + 64 + quad * 16);
                    at[sb] = mfma16(a0, qb[0], at[sb]); at[sb] = mfma16(a1, qb[1], at[sb]);
                    if (sb == tb) {
#pragma unroll
                        for (int j = 0; j < 4; ++j) if (4 * quad + j > l15) at[sb][j] = 0.f; } } }
            bf16x8 pf[2];
#pragma unroll
            for (int kh = 0; kh < 2; ++kh) { u32x4 w; w.x = pk(at[2 * kh][0], at[2 * kh][1]); w.y = pk(at[2 * kh][2], at[2 * kh][3]); w.z = pk(at[2 * kh + 1][0], at[2 * kh + 1][1]); w.w = pk(at[2 * kh + 1][2], at[2 * kh + 1][3]); pf[kh] = __builtin_bit_cast(bf16x8, w); }
#pragma unroll
            for (int dvb = 0; dvb < 4; ++dvb) { const int dvrow = 16 * (4 * half + dvb) + l15; f32x4 oacc = (f32x4){0.f, 0.f, 0.f, 0.f};
#pragma unroll
                for (int kh = 0; kh < 2; ++kh) if (2 * kh <= tb) { const LAS unsigned char* vp = lds + GL_VT + dvrow * 144 + (32 * kh + 4 * quad) * 2;
                    const bf16x4 lo = *(const LAS bf16x4*)vp, hi = *(const LAS bf16x4*)(vp + 32);
                    oacc = mfma16((bf16x8){lo[0], lo[1], lo[2], lo[3], hi[0], hi[1], hi[2], hi[3]}, pf[kh], oacc); }
#pragma unroll
                for (int ks = 0; ks < 2; ++ks) { const bf16x8 sf = *(const LAS bf16x8*)(lds + GL_ST + cur * 18432 + dvrow * 144 + ks * 64 + quad * 16); oacc = mfma16(sf, qb[ks], oacc); }
                *(LAS f32x4*)(lds + GL_OB + ((16 * tb + l15) * 132 + 16 * (4 * half + dvb) + 4 * quad) * 4) = oacc; }
#pragma unroll
            for (int mb = 0; mb < 4; ++mb) { const f32x4 d = *(const LAS f32x4*)(lds + GL_BLD + (16 * mb + 4 * quad) * 4); sacc[mb] *= d;
#pragma unroll
                for (int ks = 0; ks < 2; ++ks) { const bf16x8 a = *(const LAS bf16x8*)(lds + GL_K2T + (16 * mb + l15) * 144 + ks * 64 + quad * 16), bfr = *(const LAS bf16x8*)(lds + GL_VT + (16 * wid + l15) * 144 + ks * 64 + quad * 16);
                    sacc[mb] = mfma16(a, bfr, sacc[mb]); }
                u32x2 w; w.x = pk(sacc[mb][0], sacc[mb][1]); w.y = pk(sacc[mb][2], sacc[mb][3]);
                *(LAS u32x2*)(lds + GL_ST + (cur ^ 1) * 18432 + (16 * wid + l15) * 144 + (16 * mb + 4 * quad) * 2) = w; }
        }
        LBAR();
        { const int t = tid >> 3, grp = tid & 7; const int lo = (c == 0) ? J.tlo0 : 0;
          f32x4 o4[4]; float q = 0.f;
#pragma unroll
          for (int i = 0; i < 4; ++i) { o4[i] = *(const LAS f32x4*)(lds + GL_OB + (t * 132 + 16 * grp + 4 * i) * 4); q += (o4[i][0] * o4[i][0] + o4[i][1] * o4[i][1]) + (o4[i][2] * o4[i][2] + o4[i][3] * o4[i][3]); }
          q += __shfl_xor(q, 1); q += __shfl_xor(q, 2); q += __shfl_xor(q, 4);
          if (t >= lo && t < J.thi) { const float r = rsqrtf(q * (1.f / 128.f) + 1e-6f); const ptrdiff_t row = (ptrdiff_t)(64 * c + t);
              const u32x4 r0 = rc[0], r1 = rc[1];
              const unsigned rw[8] = {r0.x, r0.y, r0.z, r0.w, r1.x, r1.y, r1.z, r1.w}; unsigned ow[8];
#pragma unroll
              for (int i = 0; i < 4; ++i) { const f32x4 on = *(const f32x4*)(J.onorm + 16 * grp + 4 * i); float y[4];
#pragma unroll
                  for (int e = 0; e < 4; ++e) { const unsigned wv = rw[2 * i + (e >> 1)]; const float rbv = __uint_as_float((e & 1) ? (wv & 0xffff0000u) : (wv << 16));
                      const float sl = rbv / (1.f + __expf(-rbv)); y[e] = o4[i][e] * r * on[e] * sl; }
                  ow[2 * i] = pk(y[0], y[1]); ow[2 * i + 1] = pk(y[2], y[3]); }
              *(u32x4*)(J.mix + row * 1024 + 16 * grp) = (u32x4){ow[0], ow[1], ow[2], ow[3]}; *(u32x4*)(J.mix + row * 1024 + 16 * grp + 8) = (u32x4){ow[4], ow[5], ow[6], ow[7]}; } }
    }
#undef GL_LOAD
#undef GL_FIX
#pragma unroll
    for (int mb = 0; mb < 4; ++mb)
#pragma unroll
        for (int j = 0; j < 4; ++j) J.sout[(size_t)(16 * mb + 4 * quad + j) * 128 + 16 * wid + l15] = sacc[mb][j];
    __syncthreads();
}

__device__ __forceinline__ int next_item(unsigned* ctr, LAS unsigned char* lds, int wv) {
    __syncthreads();
    if (wv == 0 && __builtin_amdgcn_mbcnt_hi(~0u, __builtin_amdgcn_mbcnt_lo(~0u, 0u)) == 0) *(LAS int*)(lds + LDS_SLOT) = (int)atomicAdd(ctr, 1u);
    __syncthreads();
    return *(const LAS int*)(lds + LDS_SLOT);
}

__device__ __forceinline__ void mixer_ab(const Params& P, LAS unsigned char* lds, int iraw, int z, int wv) {
    unsigned* ctr = (unsigned*)(P.ws + z + WS_CTL) + iraw; const int i = iraw & 7;
    const int wid = wv;
    constexpr int N_GP = 64, N_GS = 64, N_SP = 16 * 33 * 2, N_SS = 32, N_ALL = N_GP + N_GS + N_SP + N_SS;
    for (;;) {
        int it = next_item(ctr, lds, wv);
        if (it >= N_ALL * PROBE_AB2) break;
        if (it >= N_ALL) it -= N_ALL;
        unsigned lz_ = 0u; asm volatile("" : "+s"(lz_)); unsigned char* ws = P.ws + z + lz_; float* out = P.out + z + lz_; unsigned char* R = ws + WS_R;
        const bf16 *QA = (const bf16*)(R + R_QA), *KA = (const bf16*)(R + R_KA), *VA = (const bf16*)(R + R_VA), *QB = (const bf16*)(R + R_QB), *KB = (const bf16*)(R + R_KB), *VB = (const bf16*)(R + R_VB), *RB = (const bf16*)(R + R_RB);
        const float* GB = (const float*)(R + R_GB); bf16* MIX = (bf16*)(ws + WS_MIX);
        const bf16* KAS = (const bf16*)(ws + WS_KAS) + (size_t)i * 16 * 160 * 128; const bf16* VAS = (const bf16*)(ws + WS_VAS) + (size_t)i * 16 * 160 * 128;
        if (it < N_GP + N_GS) {
            const bool samp = it >= N_GP; const int u = samp ? it - N_GP : it, b = u >> 2, hb = u & 3;
            const ptrdiff_t r0 = samp ? (ptrdiff_t)(MP + b * 32) : (ptrdiff_t)(b * LP - 48);
            GlaJob J; J.q = QB + r0 * 256 + hb * 64; J.k = KB + r0 * 256 + hb * 64; J.g = GB + r0 * 256 + hb * 64; J.v = VB + r0 * 512 + hb * 128; J.rb = RB + r0 * 512 + hb * 128;
            J.mix = MIX + r0 * 1024 + 512 + hb * 128; J.onorm = IN(17) + (size_t)i * 128;
            J.s0 = samp ? IN(4) + ((size_t)(i * 16 + b) * 4 + hb) * 8192 : nullptr;
            J.sout = out + (samp ? O_BS : O_BP) + ((size_t)(i * 16 + b) * 4 + hb) * 8192;
            J.nchunks = samp ? 1 : 33; J.tlo0 = samp ? 0 : 48; J.thi = samp ? 32 : 64;
            for (int rr = 0; rr < ((PROBE_GLA2 && !samp) ? 2 : 1); ++rr) gla_unit(lds, J, wv);
        } else if (it < N_GP + N_GS + N_SP) {
            const int u = it - N_GP - N_GS, kvh = u & 1, c = (u >> 1) % 33, b = (u >> 1) / 33;
            const ptrdiff_t rq = (ptrdiff_t)b * LP + 64 * c - 48, rk = (ptrdiff_t)b * LP + 64 * (c - 2) - 48;
            AttnBlk B; B.k = KA + rk * 128 + kvh * 64; B.v = VA + rk * 128 + kvh * 64; B.lf = nullptr; B.kld = 128; B.vld = 128; B.lfld = 0; B.q0pos = 0; B.qkb = 0.f;
            B.klo = 48 - 64 * (c - 2); if (B.klo < 0) B.klo = 0; B.khi = 192; B.t0 = B.klo >> 6; B.t1 = 3;
            const int g = wid >> 1, hf = wid & 1, head = kvh * 4 + g;
            AttnWave W; W.q = QA + (rq + 32 * hf) * 512 + head * 64; W.o = MIX + (rq + 32 * hf) * 1024 + head * 64; W.qld = 512; W.old = 1024;
            W.ilo = (c == 0) ? (48 - 32 * hf) : 0; if (W.ilo < 0) W.ilo = 0; W.ihi = 32; W.active = W.ilo < 32; if (!W.active) { W.ilo = 0; }
            W.qpos = 0; W.sink2 = IN(14)[i * 8 + head] * LOG2E;
            attn_unit<false>(lds, B, W, wv);
        } else {
            const int u = it - N_GP - N_GS - N_SP, kvh = u & 1, b = u >> 1;
            AttnBlk B; B.k = KAS + (size_t)b * 160 * 128 + kvh * 64; B.v = VAS + (size_t)b * 160 * 128 + kvh * 64; B.lf = nullptr; B.kld = 128; B.vld = 128; B.lfld = 0; B.q0pos = 0; B.qkb = 0.f; B.klo = 0; B.khi = 160; B.t0 = 0; B.t1 = 3;
            const int g = wid & 3, head = kvh * 4 + g; const ptrdiff_t rq = (ptrdiff_t)MP + b * 32;
            AttnWave W; W.q = QA + rq * 512 + head * 64; W.o = MIX + rq * 1024 + head * 64; W.qld = 512; W.old = 1024; W.ilo = 0; W.ihi = 32; W.active = wid < 4; W.qpos = 0; W.sink2 = IN(14)[i * 8 + head] * LOG2E;
            attn_unit<false>(lds, B, W, wv);
        }
    }
    if (iraw == 0) {
        unsigned char* ws = P.ws + z; unsigned* ctr2 = (unsigned*)(ws + WS_CTL) + 6; const int lane = (int)__builtin_amdgcn_mbcnt_hi(~0u, __builtin_amdgcn_mbcnt_lo(~0u, 0u));
        LAS float* scr = (LAS float*)(lds + wv * 16384);
        for (;;) { const int blk = next_item(ctr2, lds, wv); const int it = WI_AB + blk * 8 + wv; if (WI_AB + blk * 8 >= WI_ALL) break; if (it < WI_ALL) WT_DISPATCH(it); }
    }
}


__device__ __forceinline__ void fox_cumsum(unsigned char* ws, const float* cache_lf, LAS unsigned char* lds, int i, int wv, int gdim, int bidx) {
    const int lane = (int)__builtin_amdgcn_mbcnt_hi(~0u, __builtin_amdgcn_mbcnt_lo(~0u, 0u)), tid = wv * 64 + lane;
    LAS float* arr = (LAS float*)lds;
    for (int u = bidx; u < 32; u += gdim) {
        const bool samp = u >= 16; const int b = samp ? u - 16 : u, N = samp ? 2080 : LP;
        float* dst = samp ? (float*)(ws + WS_LFS) + ((size_t)i * 16 + b) * 2080 * 16 : (float*)(ws + WS_R + R_LF) + (size_t)b * LP * 16;
        const float* csrc = cache_lf + ((size_t)i * 16 + b) * 2048 * 16;
        __syncthreads();
        for (int e = tid; e < N * 16; e += 512) { const int pos = e >> 4, h = e & 15; arr[pos * 17 + h] = (samp && pos < 2048) ? csrc[e] : dst[e]; }
        __syncthreads();
#pragma unroll 1
        for (int hh = 0; hh < 2; ++hh) { const int h = 2 * wv + hh; float carry = 0.f;
            for (int p0 = 0; p0 < N; p0 += 64) { const int pos = p0 + lane; float x = pos < N ? arr[pos * 17 + h] : 0.f;
#pragma unroll
                for (int o = 1; o < 64; o <<= 1) { const float y = __shfl_up(x, o); if (lane >= o) x += y; }
                if (pos < N) arr[pos * 17 + h] = (carry + x) * LOG2E; carry += __shfl(x, 63); } }
        __syncthreads();
        for (int e = tid; e < N * 16; e += 512) dst[e] = arr[(e >> 4) * 17 + (e & 15)];
    }
    __syncthreads();
}

__device__ __forceinline__ void mixer_c(const Params& P, LAS unsigned char* lds, int iraw, int z, int wv) {
    unsigned* ctr = (unsigned*)(P.ws + z + WS_CTL) + 2 + iraw; const int i = iraw & 7;
    const int wid = wv;
    constexpr int N_P = 9 * 256, N_ALL = N_P + 256;
    float qkb;
    { const int ln = (int)__builtin_amdgcn_mbcnt_hi(~0u, __builtin_amdgcn_mbcnt_lo(~0u, 0u)); float mq = fabsf(IN(21)[i * 64 + ln]), mk = fabsf(IN(22)[i * 64 + ln]);
#pragma unroll
      for (int o = 1; o < 64; o <<= 1) { mq = fmaxf(mq, __shfl_xor(mq, o)); mk = fmaxf(mk, __shfl_xor(mk, o)); }
      qkb = 8.f * LOG2E * mq * mk * 1.02f + 2.f; }
    for (;;) {
        int it = next_item(ctr, lds, wv);
        if (it >= N_ALL * PROBE_C2) break;
        if (it >= N_ALL) it -= N_ALL;
        unsigned lz_ = 0u; asm volatile("" : "+s"(lz_)); unsigned char* ws = P.ws + z + lz_; unsigned char* R = ws + WS_R;
        const bf16 *QC = (const bf16*)(R + R_QC), *KC = (const bf16*)(R + R_KC), *VC = (const bf16*)(R + R_VC); const float* LF = (const float*)(R + R_LF);
        const bf16* KCS = (const bf16*)(ws + WS_KCS) + (size_t)i * 16 * 2080 * 1024; const bf16* VCS = (const bf16*)(ws + WS_VCS) + (size_t)i * 16 * 2080 * 1024; const float* LFS = (const float*)(ws + WS_LFS) + (size_t)i * 16 * 2080 * 16;
        bf16* MIX = (bf16*)(ws + WS_MIX);
        AttnBlk B; AttnWave W;
        if (it < N_P) {
            const int kb = 8 - it / 256, bh = it % 256, b = bh >> 4, h = bh & 15;
            const int q0 = (kb == 0) ? 0 : 16 + 256 * (kb - 1), nst = (kb == 0) ? 16 : 256;
            const ptrdiff_t rb = (ptrdiff_t)b * LP;
            B.k = KC + rb * 1024 + h * 64; B.v = VC + rb * 1024 + h * 64; B.lf = LF + rb * 16 + h; B.kld = 1024; B.vld = 1024; B.lfld = 16; B.klo = 0; B.khi = LP; B.t0 = 0; B.q0pos = q0; B.qkb = qkb;
            B.t1 = (q0 + nst + 63) >> 6;
            W.q = QC + (rb + q0 + 32 * wid) * 1024 + h * 64; W.o = MIX + (rb + q0 + 32 * wid) * 1024 + h * 64; W.qld = 1024; W.old = 1024;
            W.ilo = 0; W.ihi = nst - 32 * wid; if (W.ihi > 32) W.ihi = 32; W.active = W.ihi > 0; if (!W.active) W.ihi = 1; W.qpos = q0 + 32 * wid; W.sink2 = 0.f;
        } else {
            const int bh = it - N_P, b = bh >> 4, h = bh & 15; const size_t ib = (size_t)i * 16 + b;
            FoxS J; J.kc = IN(5) + (ib * 2048 * 16 + h) * 64; J.vc = IN(6) + (ib * 2048 * 16 + h) * 64; J.lf = LFS + (size_t)b * 2080 * 16 + h;
            J.kn = KCS + ((size_t)b * 2080 + 2048) * 1024 + h * 64; J.vn = VCS + ((size_t)b * 2080 + 2048) * 1024 + h * 64;
            J.q = QC + ((size_t)MP + b * 32) * 1024 + h * 64; J.o = MIX + ((size_t)MP + b * 32) * 1024 + h * 64; J.qkb = qkb;
            fox_sample_unit(lds, J, wv);
            continue;
        }
        attn_unit<true>(lds, B, W, wv);
    }
}

#define XB_TMO      128
#define XB_XCNT(j)  (256  + 64 * (j))
#define XB_XSUB(j)  (1280 + 64 * (j))
#define XB_XGEN(j)  (2304 + 64 * (j))
#define XB_TOP      3328
#define XB_TOPGEN   3392
#define XCD_BAR_WORDS 3456
#define XB_SPIN_CAP (1u << 18)

__device__ __forceinline__ unsigned xb_ld(unsigned* p)              { return __hip_atomic_load(p, __ATOMIC_RELAXED, __HIP_MEMORY_SCOPE_AGENT); }
__device__ __forceinline__ unsigned xb_add(unsigned* p, unsigned v) { return __hip_atomic_fetch_add(p, v, __ATOMIC_RELAXED, __HIP_MEMORY_SCOPE_AGENT); }
__device__ __forceinline__ unsigned xb_xcc_id() { return (unsigned)__builtin_amdgcn_s_getreg((3 << 11) | 20) & 0xFu; }
#define XB_SPIN(cond, bar) do { unsigned _sp = 0; while (cond) { __builtin_amdgcn_s_sleep(1); \
    if ((++_sp & 255u) == 0u) { if (xb_ld(&(bar)[XB_TMO])) break; if (_sp > XB_SPIN_CAP) { atomicAdd(&(bar)[XB_TMO], 1u); break; } } } } while (0)

struct XcdBarrier {
    unsigned* bar; unsigned x;
    volatile LAS unsigned* st;
};

__device__ __forceinline__ XcdBarrier xcd_barrier_post(unsigned* bar, volatile LAS unsigned* st, int wv) {
    const bool leader = (wv == 0) && (__builtin_amdgcn_mbcnt_hi(~0u, __builtin_amdgcn_mbcnt_lo(~0u, 0u)) == 0u);
    XcdBarrier b; b.bar = bar; b.x = xb_xcc_id(); b.st = st;
    if (leader) (void)xb_add(&bar[XB_XCNT(b.x)], 1u);
    return b;
}
__device__ __forceinline__ void xcd_barrier_complete(unsigned* bar, unsigned x, unsigned& nloc, unsigned& nx) {
    const unsigned G = gridDim.x * gridDim.y * gridDim.z;
    unsigned sum, cnt, mine, sp = 0u;
    for (;;) {
        sum = 0u; cnt = 0u; mine = 0u;
#pragma unroll
        for (unsigned j = 0; j < 16; ++j) { const unsigned c = xb_ld(&bar[XB_XCNT(j)]); sum += c; cnt += (c > 0u) ? 1u : 0u; mine = (j == x) ? c : mine; }
        if (sum == G) break;
        __builtin_amdgcn_s_sleep(1);
        if ((++sp & 255u) == 0u) { if (xb_ld(&bar[XB_TMO])) break; if (sp > XB_SPIN_CAP) { atomicAdd(&bar[XB_TMO], 1u); break; } }
    }
    nloc = mine > 0u ? mine : 1u; nx = cnt > 0u ? cnt : 1u;
}

__device__ __forceinline__ void xcd_barrier(const XcdBarrier& b, int wv) {
    const bool leader = (wv == 0) && (__builtin_amdgcn_mbcnt_hi(~0u, __builtin_amdgcn_mbcnt_lo(~0u, 0u)) == 0u);
    asm volatile("s_waitcnt vmcnt(0)" ::: "memory");
    __syncthreads();
    if (leader) {
        unsigned* bar = b.bar; const unsigned bx = b.x;
        __builtin_amdgcn_s_waitcnt(0);
        unsigned nloc = b.st[0], nx = b.st[1];
        if (nloc == 0u) { xcd_barrier_complete(bar, bx, nloc, nx); b.st[0] = nloc; b.st[1] = nx; }
        const unsigned old = xb_add(&bar[XB_XSUB(bx)], 1u);
        const unsigned gen = old / nloc;
        if (old + 1u == (gen + 1u) * nloc) {
            __builtin_amdgcn_fence(__ATOMIC_RELEASE, "agent");
            asm volatile("s_waitcnt vmcnt(0)" ::: "memory");
            const unsigned og = xb_add(&bar[XB_TOP], 1u);
            const unsigned tg = og / nx;
            if (og + 1u == (tg + 1u) * nx) xb_add(&bar[XB_TOPGEN], 1u);
            else XB_SPIN(xb_ld(&bar[XB_TOPGEN]) == tg, bar);
            __builtin_amdgcn_fence(__ATOMIC_ACQUIRE, "agent");
            xb_add(&bar[XB_XGEN(bx)], 1u);
            asm volatile("s_waitcnt vmcnt(0)" ::: "memory");
        } else {
            XB_SPIN(xb_ld(&bar[XB_XGEN(bx)]) == gen, bar);
            __builtin_amdgcn_fence(__ATOMIC_ACQUIRE, "agent");
            asm volatile("s_waitcnt vmcnt(0)" ::: "memory");
        }
    }
    __syncthreads();
}

__device__ __forceinline__ void tail_reduce(unsigned char* ws, float* out, float* ssout, float* rsout, bool fin, int wv, int gdim, int bidx) {
    const int lane = (int)__builtin_amdgcn_mbcnt_hi(~0u, __builtin_amdgcn_mbcnt_lo(~0u, 0u));
    float* X = (float*)(ws + WS_X); bf16* XB = (bf16*)(ws + WS_XB); const float* PB = (const float*)(ws + WS_PB);
    for (int r = bidx * 8 + wv; r < 768; r += gdim * 8) { const int row = 32768 + r; float part = 0.f;
        float* op = nullptr; bool ok = true;
        if (fin) { if (row < MP) { const int b = row / LP, p = row - b * LP; ok = p >= 16; op = out + O_YP + ((size_t)(b * 2048 + p - 16)) * 1024; } else op = out + O_YS + (size_t)(row - MP) * 1024; }
#pragma unroll
        for (int k = 0; k < 4; ++k) { const int col = 16 * lane + 4 * k; const u32x2 xr = *(const u32x2*)(XB + (size_t)row * 1024 + col);
            f32x4 x = (f32x4){__uint_as_float(xr.x << 16), __uint_as_float(xr.x & 0xffff0000u), __uint_as_float(xr.y << 16), __uint_as_float(xr.y & 0xffff0000u)};
#pragma unroll
            for (int q = 0; q < 4; ++q) x += *(const f32x4*)(PB + ((size_t)q * 768 + r) * 1024 + col);
            if (fin) { if (ok) *(f32x4*)(op + col) = x; }
            else { u32x2 w; w.x = pk(x[0], x[1]); w.y = pk(x[2], x[3]); *(u32x2*)(XB + (size_t)row * 1024 + col) = w;
                part += (x[0] * x[0] + x[1] * x[1]) + (x[2] * x[2] + x[3] * x[3]); } }
        if (!fin && ssout) { part = wave_sum(part); if (lane == 0) rsout[row] = rsqrtf(part * (1.f / 1024.f) + 1e-6f); } }
    if (!fin && ssout) for (int row = bidx * 512 + wv * 64 + lane; row < 32768; row += gdim * 512) { const f32x4* p = (const f32x4*)(ssout + (size_t)row * 16); const f32x4 a = p[0], b = p[1], c = p[2], d = p[3];
        const float s = (((a[0] + a[1]) + (a[2] + a[3])) + ((b[0] + b[1]) + (b[2] + b[3]))) + (((c[0] + c[1]) + (c[2] + c[3])) + ((d[0] + d[1]) + (d[2] + d[3]))); rsout[row] = rsqrtf(s * (1.f / 1024.f) + 1e-6f); }
}
#ifndef PROBE_REP
#define PROBE_REP (-1)
#endif
__global__ void __launch_bounds__(512, 2) hybrid_fwd(Params P) {
    extern __shared__ __attribute__((aligned(16))) unsigned char lds_raw[];
    LAS unsigned char* lds = (LAS unsigned char*)lds_raw;
    if (P.coop == 2) { __threadfence(); cg::this_grid().sync(); }
    const int wv = __builtin_amdgcn_readfirstlane((int)(threadIdx.x >> 6));
    if (P.coop) { volatile LAS unsigned* st = (volatile LAS unsigned*)(lds + LDS_SLOT + 16); if (wv == 0) { st[0] = 0u; st[1] = 0u; } __syncthreads(); (void)xcd_barrier_post((unsigned*)(P.ws + WS_BAR), st, wv); }
    for (int ph = P.ph_lo; ph < P.ph_hi; ++ph) {
        int z; asm volatile("s_mov_b32 %0, 0" : "=s"(z));
        unsigned char* ws = P.ws + z; float* out = P.out + z; const int gdim = (int)gridDim.x + z, bidx = (int)blockIdx.x + z;
        unsigned char* R = ws + WS_R; float* SS = (float*)(ws + WS_SS);
#define IN(k) (P.in[(k) + z])
        int nrep = 1;
        { const int l_ = (ph - 1) / 5, k_ = (ph - 1) % 5; const bool ev_ = (l_ & 1) == 0;
          if (PROBE_REP == 100 && ph == 0) nrep = 2;
          if (ph > 0 && ((PROBE_REP == 0 && k_ == 0) || (PROBE_REP == 1 && k_ == 1 && ev_) || (PROBE_REP == 11 && k_ == 1 && !ev_) || (PROBE_REP == 3 && k_ == 3) || (PROBE_REP == 4 && k_ == 4) || (PROBE_REP == 2 && k_ == 2))) nrep = 2; }
        for (int rep = 0; rep < nrep; ++rep) {
        if (ph == 0) {
#ifndef NO_PRO
            prologue(P, lds, z, wv, gdim, bidx);
#endif
        } else {
            const int l = (ph - 1) / 5, kind = (ph - 1) % 5, i = l >> 1; const bool even = (l & 1) == 0;
            if (kind == 0) {
                if (even) {
#ifndef NO_AB
                    pg8::Gemm g{(const pg8::bf16_t*)(ws + WS_XB), (const pg8::bf16_t*)(ws + WS_WAB) + (size_t)i * NAB * 1024, MT, NAB, 1024, 1024};
                    pg8::StaticOrder S; S.init(MT, NAB, gdim, bidx);
                    pg8::EpiAB E{ws, out, (const float*)(ws + WS_RS) + (size_t)(2 * l) * MT, IN(12) + i * 64, IN(13) + i * 64, IN(16) + i * 256, i};
                    pg8::gemm_phase<pg8::EpiAB, pg8::StaticOrder, true, true>(lds, g, S, E, wv);
#endif
                } else {
#ifndef NO_C
                    pg8::Gemm g{(const pg8::bf16_t*)(ws + WS_XB), (const pg8::bf16_t*)(ws + WS_WC) + (size_t)i * NC * 1024, MT, NC, 1024, 1024};
                    pg8::StaticOrder S; S.init(MT, NC, gdim, bidx);
                    pg8::EpiC E{ws, out, (const float*)(ws + WS_RS) + (size_t)(2 * l) * MT, IN(21) + i * 64, IN(22) + i * 64, IN(20) + i * 16, i};
                    pg8::gemm_phase<pg8::EpiC, pg8::StaticOrder, true, true>(lds, g, S, E, wv);
#endif
                }
            } else if (kind == 1) {
#ifndef NO_MIXAB
                if (even) mixer_ab(P, lds, i + 8 * rep, z, wv);
#endif
#ifndef NO_MIXC
                if (!even) { fox_cumsum(ws, IN(7), lds, i, wv, gdim, bidx);
                    { XcdBarrier bb; bb.bar = (unsigned*)(ws + WS_BAR); bb.x = xb_xcc_id(); bb.st = (volatile LAS unsigned*)(lds + LDS_SLOT + 16); xcd_barrier(bb, wv); }
                    mixer_c(P, lds, i + 8 * rep, z, wv); }
#endif
            } else if (kind == 3) {
                pg8::Gemm g{(const pg8::bf16_t*)(ws + WS_XB), (const pg8::bf16_t*)(ws + WS_WUP) + (size_t)l * 4194304, MT, DFF, 1024, 1024};
                pg8::StaticOrder S; S.init(MT, DFF, gdim, bidx);
                pg8::EpiUp E{ws, (const float*)(ws + WS_RS) + (size_t)(2 * l + 1) * MT};
#ifndef NO_UP
                pg8::gemm_phase<pg8::EpiUp, pg8::StaticOrder, true, true>(lds, g, S, E, wv);
#endif
            } else {
                const bool down = kind == 4;
                const pg8::bf16_t* A = down ? (const pg8::bf16_t*)R : (const pg8::bf16_t*)(ws + WS_MIX);
                const pg8::bf16_t* Bt = down ? (const pg8::bf16_t*)(ws + WS_WDN) + (size_t)l * 4194304 : (even ? (const pg8::bf16_t*)(ws + WS_WOAB) + (size_t)i * 1048576 : (const pg8::bf16_t*)(ws + WS_WOC) + (size_t)i * 1048576);
                const int Kd = down ? 4096 : 1024;
                pg8::Gemm g{A, Bt, 128 * 256, 1024, Kd, Kd};
                pg8::StaticOrder S; S.init(128 * 256, 1024, gdim, bidx);
                const bool fin = down && l == 3;
                float* ssout = fin ? nullptr : SS + (size_t)(down ? 2 * l + 2 : 2 * l + 1) * MT * 16;
                const bool dry = (PROBE_REP == 4 || PROBE_REP == 2) && nrep == 2 && rep == 0;
                pg8::EpiRes E{ws, ssout, dry ? 2 : (fin ? 1 : 0), out};
#ifndef NO_RES
                pg8::gemm_phase<pg8::EpiRes, pg8::StaticOrder, true, true>(lds, g, S, E, wv);
                if (!dry) { pg8::Gemm g2{A, Bt, MT, 1024, Kd, Kd / 4}; pg8::TailOrder T{gdim, bidx, Kd / 4}; pg8::EpiPart E2{ws, Kd / 4};
                  pg8::gemm_phase<pg8::EpiPart, pg8::TailOrder, true, true>(lds, g2, T, E2, wv); }
                if (!dry) { XcdBarrier bb; bb.bar = (unsigned*)(ws + WS_BAR); bb.x = xb_xcc_id(); bb.st = (volatile LAS unsigned*)(lds + LDS_SLOT + 16); xcd_barrier(bb, wv);
                tail_reduce(ws, out, ssout, (float*)(ws + WS_RS) + (size_t)(down ? 2 * l + 2 : 2 * l + 1) * MT, fin, wv, gdim, bidx); }
#endif
            }
        }
        if (rep + 1 < nrep && P.coop == 1) { XcdBarrier bb; bb.bar = (unsigned*)(ws + WS_BAR); bb.x = xb_xcc_id(); bb.st = (volatile LAS unsigned*)(lds + LDS_SLOT + 16); xcd_barrier(bb, wv); }
        }
        for (int xb_ = 0; xb_ < PROBE_XBAR; ++xb_) { XcdBarrier bb; bb.bar = (unsigned*)(ws + WS_BAR); bb.x = xb_xcc_id(); bb.st = (volatile LAS unsigned*)(lds + LDS_SLOT + 16); xcd_barrier(bb, wv); }
        if (P.coop == 1 && ph + 1 < P.ph_hi) { XcdBarrier bb; bb.bar = (unsigned*)(ws + WS_BAR); bb.x = xb_xcc_id(); bb.st = (volatile LAS unsigned*)(lds + LDS_SLOT + 16); xcd_barrier(bb, wv); }
        else __syncthreads();
    }
}

#ifndef ONE_LAUNCH
#define ONE_LAUNCH 1
#endif
extern "C" void kernel_launch(void* const* d_in, const int* in_sizes, int n_in, void* d_out, int out_size, void* d_ws, size_t ws_size, hipStream_t stream) {
    static int grid = 0;
    if (grid == 0) {
        if (n_in != 26 || (size_t)out_size != O_END || ws_size < WS_END) { fprintf(stderr, "kernel_launch: unexpected shapes: n_in %d out %d ws %zu (need %zu)\n", n_in, out_size, ws_size, (size_t)WS_END); grid = -1; return; }
        int dev = 0, cus = 0, per_cu = 0;
        hipGetDevice(&dev); hipDeviceGetAttribute(&cus, hipDeviceAttributeMultiprocessorCount, dev);
        hipFuncSetAttribute((const void*)hybrid_fwd, hipFuncAttributeMaxDynamicSharedMemorySize, LDS_BYTES);
        if (hipOccupancyMaxActiveBlocksPerMultiprocessor(&per_cu, (const void*)hybrid_fwd, 512, LDS_BYTES) != hipSuccess || per_cu < 1) per_cu = 1;
        (void)hipGetLastError();
        grid = cus * per_cu;
    }
    if (grid < 0) return;
    Params p{};
    for (int i = 0; i < 26; ++i) p.in[i] = (const float*)d_in[i];
    p.out = (float*)d_out; p.ws = (unsigned char*)d_ws;
#if ONE_LAUNCH
    p.ph_lo = 0; p.ph_hi = 21; p.coop = 1;
    if (hipMemsetAsync((char*)d_ws + WS_BAR, 0, 16384, stream) != hipSuccess) { fprintf(stderr, "kernel_launch: memset of the barrier words failed\n"); return; }
    void* args[] = {&p};
    hipError_t e = hipLaunchCooperativeKernel((const void*)hybrid_fwd, dim3(grid), dim3(512), args, LDS_BYTES, stream);
    if (e != hipSuccess) fprintf(stderr, "cooperative launch failed: %s (grid %d)\n", hipGetErrorString(e), grid);
#else
    for (int ph = 0; ph < 21; ++ph) { p.ph_lo = ph; p.ph_hi = ph + 1; p.coop = 0; hipLaunchKernelGGL(hybrid_fwd, dim3(grid), dim3(512), LDS_BYTES, stream, p); }
#endif
}
```
